# Optimizing an MI355X kernel written in HIP

```python
import jax, jax.numpy as jnp
from jax import lax
import numpy as np

D_MODEL = 2048
BATCH = 2
SEQ = 16384
DEPTH = 2

HEAD_DIM = 128
CHUNK = 128
A_GROUPS = D_MODEL // 256
D_A = A_GROUPS * HEAD_DIM
ATTN_PATTERNS = ((128, 1), (512, 4), (2048, 16))
HEADS_PER_GROUP = D_MODEL // 512
B_HEADS = HEADS_PER_GROUP * len(ATTN_PATTERNS)
D_B = B_HEADS * HEAD_DIM
D_B_OUT = HEADS_PER_GROUP * HEAD_DIM
D_FF = 4 * D_MODEL
Q_BLOCK = 128
ALIBI_MAX_EXP = 8.0
EPS = 1e-6
SPLITS = (D_A, 2 * D_A, 2 * D_A + D_B, 2 * D_A + 2 * D_B, 2 * D_A + 3 * D_B,
          2 * D_A + 3 * D_B + D_MODEL)
IN_COLS = 2 * D_A + 3 * D_B + 2 * D_MODEL

kernel_name = 'hybrid_gmlp_dilated_attn_gated_block'


def _rmsnorm(x, g):
    xf = x.astype(jnp.float32)
    y = xf * lax.rsqrt(jnp.mean(xf * xf, axis=-1, keepdims=True) + EPS)
    return (y * g.astype(jnp.float32)).astype(x.dtype)


def _layernorm(x, g, b):
    xf = x.astype(jnp.float32)
    mu = jnp.mean(xf, axis=-1, keepdims=True)
    var = jnp.mean(jnp.square(xf - mu), axis=-1, keepdims=True)
    y = (xf - mu) * lax.rsqrt(var + EPS)
    return (y * g.astype(jnp.float32) + b.astype(jnp.float32)).astype(x.dtype)


def _modulate(h, shift, scale):
    return h * (1 + scale[:, None, :]) + shift[:, None, :]


def _spatial_gating(u, v, w_s, b_s):
    bsz, seq, _ = v.shape
    n_chunks = seq // CHUNK
    causal = jnp.tril(jnp.ones((CHUNK, CHUNK), dtype=w_s.dtype))
    vc = v.reshape(bsz, n_chunks, CHUNK, A_GROUPS, HEAD_DIM)
    fv = jnp.einsum('gts,bnsgc->bntgc', w_s * causal, vc) + b_s.T[None, None, :, :, None]
    return u * fv.reshape(bsz, seq, D_A)


def _dilated_window_attention(q, k, v, window, dilation, slopes):
    bsz, seq, nh, hd = q.shape
    span = window // dilation
    m = seq // dilation
    nb = -(-m // Q_BLOCK)
    mp = nb * Q_BLOCK

    def to_blocks(t):
        t = t.reshape(bsz, m, dilation, nh, hd).transpose(0, 2, 3, 1, 4)
        t = jnp.pad(t, ((0, 0), (0, 0), (0, 0), (0, mp - m), (0, 0)))
        return t.reshape(bsz, dilation, nh, nb, Q_BLOCK, hd)

    def with_prev(t):
        prev = jnp.concatenate([jnp.zeros_like(t[:, :, :, :1]), t[:, :, :, :-1]], axis=3)
        return jnp.concatenate([prev, t], axis=4)

    qb = to_blocks(q * HEAD_DIM ** -0.5)
    kb = with_prev(to_blocks(k))
    vb = with_prev(to_blocks(v))
    scores = jnp.einsum('brhnqc,brhnkc->brhnqk', qb, kb, preferred_element_type=jnp.float32)
    qi = jnp.arange(Q_BLOCK)[:, None] + Q_BLOCK
    ki = jnp.arange(2 * Q_BLOCK)[None, :]
    dist = qi - ki
    blk = jnp.arange(nb)[:, None, None]
    valid = (dist >= 0) & (dist <= span) & (blk * Q_BLOCK + ki - Q_BLOCK >= 0)
    alibi = -slopes[:, None, None] * (dilation * dist).astype(jnp.float32)
    scores = jnp.where(valid[None, None, None], scores + alibi[None, None, :, None], -jnp.inf)
    lse = jax.nn.logsumexp(scores, axis=-1)
    probs = jnp.exp(scores - lse[..., None])
    out = jnp.einsum('brhnqk,brhnkc->brhnqc', probs, vb.astype(jnp.float32))
    out = out.reshape(bsz, dilation, nh, mp, hd)[:, :, :, :m]
    out = out.transpose(0, 3, 1, 2, 4).reshape(bsz, seq, nh, hd)
    lse = lse.reshape(bsz, dilation, nh, mp)[:, :, :, :m]
    lse = lse.transpose(0, 3, 1, 2).reshape(bsz, seq, nh)
    return out, lse


def _hybrid_mixer(h, w_in, b_in, g_v, b_v, w_s, b_s, w_oa, w_ob, w_out):
    bsz, seq, _ = h.shape
    proj = h @ w_in + b_in
    u_a, v_a, q, k, v, gate_a, gate_b = jnp.split(proj, SPLITS, axis=-1)
    y_a = _spatial_gating(jax.nn.gelu(u_a), _layernorm(jax.nn.gelu(v_a), g_v, b_v), w_s, b_s)
    q = q.reshape(bsz, seq, B_HEADS, HEAD_DIM)
    k = k.reshape(bsz, seq, B_HEADS, HEAD_DIM)
    v = v.reshape(bsz, seq, B_HEADS, HEAD_DIM)
    slopes = 2.0 ** (-ALIBI_MAX_EXP * jnp.arange(1, B_HEADS + 1, dtype=jnp.float32) / B_HEADS)
    outs, lses = [], []
    for g, (window, dilation) in enumerate(ATTN_PATTERNS):
        hs = slice(g * HEADS_PER_GROUP, (g + 1) * HEADS_PER_GROUP)
        o, l = _dilated_window_attention(q[:, :, hs], k[:, :, hs], v[:, :, hs],
                                         window, dilation, slopes[hs])
        outs.append(o)
        lses.append(l)
    weights = jax.nn.softmax(jnp.stack(lses), axis=0)
    y_b = jnp.sum(weights[..., None] * jnp.stack(outs), axis=0)
    y_b = y_b.reshape(bsz, seq, D_B_OUT).astype(h.dtype)
    merged = jax.nn.sigmoid(gate_a) * (y_a @ w_oa) + jax.nn.sigmoid(gate_b) * (y_b @ w_ob)
    return merged @ w_out


def _sq_relu_mlp(h, w1, b1, w2, b2):
    return jnp.square(jax.nn.relu(h @ w1 + b1)) @ w2 + b2


def setup_inputs(seed: int = 0) -> dict:
    key = jax.random.key(seed)
    ks = jax.random.split(key, 24)
    L = DEPTH
    f32 = jnp.float32

    def nrm(k, shape, fan_in):
        return jax.random.normal(k, shape, f32) * fan_in ** -0.5

    def small(k, shape):
        return 0.02 * jax.random.normal(k, shape, f32)

    return {
        'x': jax.random.normal(ks[0], (BATCH, SEQ, D_MODEL), f32),
        'c': jax.random.normal(ks[1], (BATCH, D_MODEL), f32),
        'w_ada': 0.5 * nrm(ks[2], (L, D_MODEL, 6 * D_MODEL), D_MODEL),
        'b_ada': small(ks[3], (L, 6 * D_MODEL)),
        'g_mix': 1.0 + small(ks[4], (L, D_MODEL)),
        'w_in': nrm(ks[5], (L, D_MODEL, IN_COLS), D_MODEL),
        'b_in': small(ks[6], (L, IN_COLS)),
        'g_v': 1.0 + small(ks[7], (L, D_A)),
        'b_v': small(ks[8], (L, D_A)),
        'w_s': nrm(ks[9], (L, A_GROUPS, CHUNK, CHUNK), CHUNK),
        'b_s': 1.0 + small(ks[10], (L, A_GROUPS, CHUNK)),
        'w_oa': nrm(ks[11], (L, D_A, D_MODEL), D_A),
        'w_ob': nrm(ks[12], (L, D_B_OUT, D_MODEL), D_B_OUT),
        'w_out': nrm(ks[13], (L, D_MODEL, D_MODEL), D_MODEL),
        'g_mlp': 1.0 + small(ks[14], (L, D_MODEL)),
        'w1': nrm(ks[15], (L, D_MODEL, D_FF), D_MODEL),
        'b1': small(ks[16], (L, D_FF)),
        'w2': nrm(ks[17], (L, D_FF, D_MODEL), D_FF),
        'b2': small(ks[18], (L, D_MODEL)),
        'g_final': 1.0 + small(ks[19], (D_MODEL,)),
    }


def reference(x, c, w_ada, b_ada, g_mix, w_in, b_in, g_v, b_v, w_s, b_s, w_oa, w_ob,
              w_out, g_mlp, w1, b1, w2, b2, g_final):
    c_act = jax.nn.silu(c)
    for l in range(DEPTH):
        mod = c_act @ w_ada[l] + b_ada[l]
        sh1, sc1, gt1, sh2, sc2, gt2 = jnp.split(mod, 6, axis=-1)
        h = _modulate(_rmsnorm(x, g_mix[l]), sh1, sc1)
        x = x + gt1[:, None, :] * _hybrid_mixer(h, w_in[l], b_in[l], g_v[l], b_v[l], w_s[l],
                                                b_s[l], w_oa[l], w_ob[l], w_out[l])
        h = _modulate(_rmsnorm(x, g_mlp[l]), sh2, sc2)
        x = x + gt2[:, None, :] * _sq_relu_mlp(h, w1[l], b1[l], w2[l], b2[l])
    return _rmsnorm(x, g_final)
```

```cpp
#include <hip/hip_runtime.h>
#include <hip/hip_cooperative_groups.h>
#include <cstdio>
#include <cstdint>
namespace cg = cooperative_groups;
#ifndef PHMASK
#define PHMASK 0xFFFFF
#endif
#define PHON(k) ((PHMASK >> (k)) & 1)
#ifndef DBG
#define DBG 0
#endif
#ifndef REP_MASK
#define REP_MASK 0
#endif
#ifndef PAIR_REP
#define PAIR_REP 0
#endif
#ifndef REP_DUMMY
#define REP_DUMMY 0
#endif
#ifndef EXTRA_SYNCS
#define EXTRA_SYNCS 0
#endif
#ifndef ONE_LAUNCH
#define ONE_LAUNCH 1
#endif
namespace pg8 {
#define PG8_LAS __attribute__((address_space(3)))
typedef unsigned short bf16_t;
typedef short bf16x8 __attribute__((ext_vector_type(8)));
typedef float f32x4 __attribute__((ext_vector_type(4)));
typedef unsigned u32x4 __attribute__((ext_vector_type(4)));
constexpr int BM = 256, BK = 64, HALF = 128, HTB = HALF * BK * 2  , STAGE_BYTES = 8 * HTB, NXCD = 8, WGM = 4;

__host__ __device__ __forceinline__ int lds_byte(int r, int c) { const int st = (r >> 4) * 2 + (c >> 5), rr = r & 15, cc = c & 31, ob = rr * 64 + cc * 2; return st * 1024 + (ob ^ (((ob >> 9) & 1) << 5)); }
__host__ __device__ __forceinline__ void stage_rc(int b, int& R, int& C) { const int st = b / 1024, sb = b % 1024, swz = sb ^ (((sb >> 9) & 1) << 5); R = (st >> 1) * 16 + swz / 64; C = (st & 1) * 32 + (swz % 64) / 2; }
__host__ __device__ __forceinline__ int perm32(int rho) { const int n = rho >> 4, i = rho & 15; return 8 * (i >> 2) + 4 * n + (i & 3); }

struct Unit { int pm, pn; };
struct Gemm { const bf16_t* A; const bf16_t* Bt; int M, N, K; };

struct StaticOrder {
    int nM, nN, nwg, G, c;
    __host__ __device__ void init(int M, int N, int G_, int c_) { nM = M / BM; nN = N / BM; nwg = nM * nN; G = G_; c = c_; }
    __host__ __device__ bool next(int i, Unit& u) const {
        const long L = (long)i * G + c; if (L >= nwg) return false;
        int wgid = (int)L; { const int q = nwg / NXCD, r = nwg % NXCD, xcd = wgid % NXCD, off = wgid / NXCD; wgid = (xcd < r ? xcd * (q + 1) : r * (q + 1) + (xcd - r) * q) + off; }
        const int nig = WGM * nN, gid = wgid / nig, fm = gid * WGM, gsz = (nM - fm) < WGM ? (nM - fm) : WGM;
        u.pm = fm + ((wgid % nig) % gsz); u.pn = (wgid % nig) / gsz; return true;
    }
    __device__ __forceinline__ void a_ready(const Unit&) const {}
    __device__ __forceinline__ void done(const Unit&) const {}
};
typedef __bf16 bf2_t __attribute__((ext_vector_type(2)));
typedef float f2_t __attribute__((ext_vector_type(2)));
__device__ __forceinline__ unsigned cvt_pk_bf16(float lo, float hi) { return __builtin_bit_cast(unsigned, __builtin_convertvector((f2_t){lo, hi}, bf2_t)); }
__device__ __forceinline__ float bflo(unsigned u) { return __uint_as_float(u << 16); }
__device__ __forceinline__ float bfhi(unsigned u) { return __uint_as_float(u & 0xffff0000u); }
__device__ __forceinline__ float act_gelu(float x) {
    const float e = __builtin_amdgcn_exp2f(x * (-2.302208198f - 0.1029432315f * x * x));
    return x * __builtin_amdgcn_rcpf(1.0f + e);
}
__device__ __forceinline__ float act_sigmoid(float x) { return __builtin_amdgcn_rcpf(1.0f + __builtin_amdgcn_exp2f(-1.4426950409f * x)); }

struct EpiInProj {
    static constexpr bool PERM = true, AFTER_DRAIN = false;
    bf16_t *U, *VA, *Q, *KK, *VV, *SGA, *SGB; const float* bias; int bstride; const float* ss;
    float* vst;
    template <int ACT, bool STATS> __device__ __forceinline__ void run(const f32x4 (&acc)[2][2][4][2], bf16_t* base, int ldc, int row0, int col0, int bcol0) const {
        f32x4 bv[2][2]; const float* bias = this->bias + (size_t)(row0 >> 14) * bstride;
#pragma unroll
        for (int bj = 0; bj < 2; ++bj)
#pragma unroll
            for (int n = 0; n < 2; ++n) bv[bj][n] = *(const f32x4*)(bias + bcol0 + bj * HALF + 4 * n);
#pragma unroll
        for (int ai = 0; ai < 2; ++ai)
#pragma unroll
            for (int m = 0; m < 4; ++m) { const int row = row0 + ai * HALF + m * 16; bf16_t* rowp = base + (size_t)row * ldc + col0;
                const float rs = ss ? __builtin_amdgcn_rsqf(ss[row] * (1.0f / 2048.0f) + 1e-6f) : 1.0f; float s1 = 0.f, s2 = 0.f;
#pragma unroll
                for (int bj = 0; bj < 2; ++bj) { f32x4 v0 = acc[ai][bj][m][0] * rs + bv[bj][0], v1 = acc[ai][bj][m][1] * rs + bv[bj][1];
                    if (ACT == 1) {
#pragma unroll
                        for (int j = 0; j < 4; ++j) { v0[j] = act_gelu(v0[j]); v1[j] = act_gelu(v1[j]); } }
                    if (ACT == 2) {
#pragma unroll
                        for (int j = 0; j < 4; ++j) { v0[j] = act_sigmoid(v0[j]); v1[j] = act_sigmoid(v1[j]); } }
                    if (STATS) { s1 += ((v0[0] + v0[1]) + (v0[2] + v0[3])) + ((v1[0] + v1[1]) + (v1[2] + v1[3])); const f32x4 q0 = v0 * v0, q1 = v1 * v1; s2 += ((q0[0] + q0[1]) + (q0[2] + q0[3])) + ((q1[0] + q1[1]) + (q1[2] + q1[3])); }
                    u32x4 w; w.x = cvt_pk_bf16(v0[0], v0[1]); w.y = cvt_pk_bf16(v0[2], v0[3]); w.z = cvt_pk_bf16(v1[0], v1[1]); w.w = cvt_pk_bf16(v1[2], v1[3]);
                    *(u32x4*)(rowp + bj * HALF) = w; }
                if (STATS) { s1 += __shfl_xor(s1, 16); s1 += __shfl_xor(s1, 32); s2 += __shfl_xor(s2, 16); s2 += __shfl_xor(s2, 32); if ((threadIdx.x & 48) == 0) { atomicAdd(vst + 2 * (size_t)row, s1); atomicAdd(vst + 2 * (size_t)row + 1, s2); } } }
    }
    __device__ __forceinline__ void operator()(const f32x4 (&acc)[2][2][4][2], const Unit& u, int wr, int wc, int fr, int fq) const {
        const int row0 = u.pm * BM + wr * 64 + fr, colt = u.pn * BM, lc = wc * 32 + 8 * fq, bcol0 = colt + lc;
        if (colt < 1024) run<1, false>(acc, U, 1024, row0, colt + lc, bcol0);
        else if (colt < 2048) run<1, true>(acc, VA, 1024, row0, colt - 1024 + lc, bcol0);
        else if (colt < 3584) run<0, false>(acc, Q, 1536, row0, colt - 2048 + lc, bcol0);
        else if (colt < 5120) run<0, false>(acc, KK, 1536, row0, colt - 3584 + lc, bcol0);
        else if (colt < 6656) run<0, false>(acc, VV, 1536, row0, colt - 5120 + lc, bcol0);
        else if (colt < 8704) run<2, false>(acc, SGA, 2048, row0, colt - 6656 + lc, bcol0);
        else run<2, false>(acc, SGB, 2048, row0, colt - 8704 + lc, bcol0);
    }
};
template <int PASS> struct EpiMerge {
    static constexpr bool PERM = true, AFTER_DRAIN = false;
    bf16_t* O; const bf16_t* G;
    __device__ __forceinline__ void operator()(const f32x4 (&acc)[2][2][4][2], const Unit& u, int wr, int wc, int fr, int fq) const {
        const int row0 = u.pm * BM + wr * 64 + fr, col0 = u.pn * BM + wc * 32 + 8 * fq;
#pragma unroll
        for (int ai = 0; ai < 2; ++ai)
#pragma unroll
            for (int m = 0; m < 4; ++m) { const size_t off = (size_t)(row0 + ai * HALF + m * 16) * 2048 + col0;
#pragma unroll
                for (int bj = 0; bj < 2; ++bj) { const u32x4 gg = *(const u32x4*)(G + off + bj * HALF);
                    f32x4 v0 = acc[ai][bj][m][0], v1 = acc[ai][bj][m][1];
                    v0[0] *= bflo(gg.x); v0[1] *= bfhi(gg.x); v0[2] *= bflo(gg.y); v0[3] *= bfhi(gg.y); v1[0] *= bflo(gg.z); v1[1] *= bfhi(gg.z); v1[2] *= bflo(gg.w); v1[3] *= bfhi(gg.w);
                    if (PASS == 2) { const u32x4 t = *(const u32x4*)(O + off + bj * HALF);
                        v0[0] += bflo(t.x); v0[1] += bfhi(t.x); v0[2] += bflo(t.y); v0[3] += bfhi(t.y); v1[0] += bflo(t.z); v1[1] += bfhi(t.z); v1[2] += bflo(t.w); v1[3] += bfhi(t.w); }
                    u32x4 w; w.x = cvt_pk_bf16(v0[0], v0[1]); w.y = cvt_pk_bf16(v0[2], v0[3]); w.z = cvt_pk_bf16(v1[0], v1[1]); w.w = cvt_pk_bf16(v1[2], v1[3]);
                    *(u32x4*)(O + off + bj * HALF) = w; }
                if (PASS == 1 ? (m == 3) : (m & 1)) asm volatile("" ::: "memory"); }
    }
};
template <int MODE> struct EpiResid {
    static constexpr bool PERM = true, AFTER_DRAIN = false;
    const float* xin32; const bf16_t* xin16; bf16_t* out; const float* gate; const float* bias;
    bf16_t* XG; const float* gcol; const float* sccol; float* ss;
    __device__ __forceinline__ void operator()(const f32x4 (&acc)[2][2][4][2], const Unit& u, int wr, int wc, int fr, int fq) const {
        const int row0 = u.pm * BM + wr * 64 + fr, col0 = u.pn * BM + wc * 32 + 8 * fq, bt = (u.pm * BM) >> 14;
        const float* gp = gate + (size_t)bt * 12288;
        f32x4 gv[2][2], bv[2][2], av[2][2];
#pragma unroll
        for (int bj = 0; bj < 2; ++bj)
#pragma unroll
            for (int n = 0; n < 2; ++n) { const int c = col0 + bj * HALF + 4 * n;
                gv[bj][n] = *(const f32x4*)(gp + c); bv[bj][n] = bias ? *(const f32x4*)(bias + c) : (f32x4){0.f, 0.f, 0.f, 0.f};
                if (MODE != 2) av[bj][n] = *(const f32x4*)(gcol + c) * (*(const f32x4*)(sccol + (size_t)bt * 12288 + c) + 1.0f); }
#pragma unroll
        for (int ai = 0; ai < 2; ++ai)
#pragma unroll
            for (int m = 0; m < 4; ++m) { const int row = row0 + ai * HALF + m * 16; const size_t off = (size_t)row * 2048 + col0; float sq = 0.f;
#pragma unroll
                for (int bj = 0; bj < 2; ++bj) { f32x4 x0, x1;
                    if (MODE == 0) { x0 = *(const f32x4*)(xin32 + off + bj * HALF); x1 = *(const f32x4*)(xin32 + off + bj * HALF + 4); }
                    else { const u32x4 xx = *(const u32x4*)(xin16 + off + bj * HALF); x0 = (f32x4){bflo(xx.x), bfhi(xx.x), bflo(xx.y), bfhi(xx.y)}; x1 = (f32x4){bflo(xx.z), bfhi(xx.z), bflo(xx.w), bfhi(xx.w)}; }
                    const f32x4 o0 = x0 + gv[bj][0] * (acc[ai][bj][m][0] + bv[bj][0]), o1 = x1 + gv[bj][1] * (acc[ai][bj][m][1] + bv[bj][1]);
                    { u32x4 w; w.x = cvt_pk_bf16(o0[0], o0[1]); w.y = cvt_pk_bf16(o0[2], o0[3]); w.z = cvt_pk_bf16(o1[0], o1[1]); w.w = cvt_pk_bf16(o1[2], o1[3]);
                      *(u32x4*)(out + off + bj * HALF) = w; }
                    const f32x4 q0 = o0 * o0, q1 = o1 * o1; sq += ((q0[0] + q0[1]) + (q0[2] + q0[3])) + ((q1[0] + q1[1]) + (q1[2] + q1[3]));
                    if (MODE != 2) { const f32x4 h0 = o0 * av[bj][0], h1 = o1 * av[bj][1];
                        u32x4 w; w.x = cvt_pk_bf16(h0[0], h0[1]); w.y = cvt_pk_bf16(h0[2], h0[3]); w.z = cvt_pk_bf16(h1[0], h1[1]); w.w = cvt_pk_bf16(h1[2], h1[3]);
                        *(u32x4*)(XG + off + bj * HALF) = w; } }
                sq += __shfl_xor(sq, 16); sq += __shfl_xor(sq, 32); if (fq == 0) atomicAdd(ss + row, sq);
                if (m & 1) asm volatile("" ::: "memory"); }
    }
};
struct EpiMlp1 {
    static constexpr bool PERM = true, AFTER_DRAIN = false;
    bf16_t* O; const float* cvec; const float* ss;
    __device__ __forceinline__ void operator()(const f32x4 (&acc)[2][2][4][2], const Unit& u, int wr, int wc, int fr, int fq) const {
        const int row0 = u.pm * BM + wr * 64 + fr, col0 = u.pn * BM + wc * 32 + 8 * fq;
        const float* cb = cvec + (size_t)((u.pm * BM) >> 14) * 8192;
        f32x4 bv[2][2];
#pragma unroll
        for (int bj = 0; bj < 2; ++bj)
#pragma unroll
            for (int n = 0; n < 2; ++n) bv[bj][n] = *(const f32x4*)(cb + col0 + bj * HALF + 4 * n);
#pragma unroll
        for (int ai = 0; ai < 2; ++ai)
#pragma unroll
            for (int m = 0; m < 4; ++m) { const int row = row0 + ai * HALF + m * 16; bf16_t* rowp = O + (size_t)row * 8192 + col0;
                const float rs = __builtin_amdgcn_rsqf(ss[row] * (1.0f / 2048.0f) + 1e-6f);
#pragma unroll
                for (int bj = 0; bj < 2; ++bj) { f32x4 v0 = acc[ai][bj][m][0] * rs + bv[bj][0], v1 = acc[ai][bj][m][1] * rs + bv[bj][1];
#pragma unroll
                    for (int j = 0; j < 4; ++j) { const float a = fmaxf(v0[j], 0.f), b = fmaxf(v1[j], 0.f); v0[j] = a * a; v1[j] = b * b; }
                    u32x4 w; w.x = cvt_pk_bf16(v0[0], v0[1]); w.y = cvt_pk_bf16(v0[2], v0[3]); w.z = cvt_pk_bf16(v1[0], v1[1]); w.w = cvt_pk_bf16(v1[2], v1[3]);
                    *(u32x4*)(rowp + bj * HALF) = w; } }
    }
};
template <class Epi, class Sched, bool ALIGN_EPI = false, bool SP2 = false>
__device__ __forceinline__ void gemm_phase(PG8_LAS unsigned char* lds, const Gemm g, const Sched& S, const Epi& E) {
    int tid_l = threadIdx.x; asm volatile("" : "+v"(tid_l));
    const int tid = tid_l, wid = __builtin_amdgcn_readfirstlane(tid >> 6), lane = tid & 63, wr = wid >> 2, wc = wid & 3, fr = lane & 15, fq = lane >> 4;
    const int K = g.K, nt = K / BK;
    unsigned voffA[2], voffB[2];
#pragma unroll
    for (int i = 0; i < 2; ++i) { int R, C; stage_rc(tid * 16 + i * 8192, R, C); const int Rb = Epi::PERM ? ((R & ~31) + perm32(R & 31)) : R;
        voffA[i] = (unsigned)(R * K + C) * 2u; voffB[i] = (unsigned)(Rb * K + C) * 2u; }
    const size_t kstep = (size_t)(BK * 2);
    const size_t hstep = (size_t)HALF * K * 2;
    const size_t tstep = 2 * hstep;
    const unsigned ldsw = (unsigned)wid * 1024u;
    const int aoff = lds_byte(wr * 64 + fr, fq * 8), boff = lds_byte(wc * 32 + fr, fq * 8);
#define PG8_SA(b, h) (((b) * 2 + (h)) * HTB)
#define PG8_SB(b, h) ((4 + (b) * 2 + (h)) * HTB)
#define PG8_STAGE(bufoff, gbase, voff) do { _Pragma("unroll") for (int _i = 0; _i < 2; ++_i) \
        __builtin_amdgcn_global_load_lds((const unsigned*)((const char*)(gbase) + (voff)[_i]), (PG8_LAS unsigned*)(lds + (bufoff) + ldsw + _i * 8192), 16, 0, 0); } while (0)
#define PG8_LDA(dst, b, h) do { _Pragma("unroll") for (int m = 0; m < 4; ++m) _Pragma("unroll") for (int k = 0; k < 2; ++k) dst[m][k] = *(const PG8_LAS bf16x8*)(lds + PG8_SA(b, h) + aoff + m * 2048 + k * 1024); } while (0)
#define PG8_LDB(dst, b, h) do { _Pragma("unroll") for (int n = 0; n < 2; ++n) _Pragma("unroll") for (int k = 0; k < 2; ++k) dst[n][k] = *(const PG8_LAS bf16x8*)(lds + PG8_SB(b, h) + boff + n * 2048 + k * 1024); } while (0)
#define PG8_MMA(ai, bj, At, Bt) do { __builtin_amdgcn_s_setprio(1); _Pragma("unroll") for (int m = 0; m < 4; ++m) _Pragma("unroll") for (int n = 0; n < 2; ++n) _Pragma("unroll") for (int k = 0; k < 2; ++k) \
        acc[ai][bj][m][n] = __builtin_amdgcn_mfma_f32_16x16x32_bf16(Bt[n][k], At[m][k], acc[ai][bj][m][n], 0, 0, 0); __builtin_amdgcn_s_setprio(0); } while (0)
#define PG8_WAIT_V(n) asm volatile("s_waitcnt vmcnt(" #n ")" ::: "memory")
#define PG8_WAIT_L(n) asm volatile("s_waitcnt lgkmcnt(" #n ")" ::: "memory")
#define PG8_BAR __builtin_amdgcn_s_barrier()
#define PG8_SCHED __builtin_amdgcn_sched_barrier(0)
    Unit cur, nxt; int ui = 0;
    if (!S.next(0, cur)) return;
    f32x4 acc[2][2][4][2];
#pragma unroll
    for (int a = 0; a < 2; ++a)
#pragma unroll
        for (int b = 0; b < 2; ++b)
#pragma unroll
            for (int m = 0; m < 4; ++m)
#pragma unroll
                for (int n = 0; n < 2; ++n) acc[a][b][m][n] = (f32x4){0.f, 0.f, 0.f, 0.f};
    bf16x8 At[4][2], B0[2][2], B1[2][2];
    const char* cA = (const char*)g.A + (size_t)cur.pm * tstep; const char* cB = (const char*)g.Bt + (size_t)cur.pn * tstep;
    S.a_ready(cur);
    if constexpr (SP2) {
        PG8_STAGE(PG8_SB(0, 0), cB, voffB); PG8_STAGE(PG8_SB(0, 1), cB + hstep, voffB); PG8_STAGE(PG8_SA(0, 0), cA, voffA); PG8_STAGE(PG8_SA(0, 1), cA + hstep, voffA);
        if (wr == 1) PG8_BAR;
        PG8_WAIT_V(2); PG8_BAR;
        PG8_STAGE(PG8_SB(1, 0), cB + kstep, voffB); PG8_STAGE(PG8_SA(1, 0), cA + kstep, voffA); PG8_STAGE(PG8_SB(1, 1), cB + hstep + kstep, voffB);
        PG8_WAIT_V(6); PG8_BAR;
    } else {
        PG8_STAGE(PG8_SB(0, 0), cB, voffB); PG8_STAGE(PG8_SA(0, 0), cA, voffA); PG8_STAGE(PG8_SB(0, 1), cB + hstep, voffB); PG8_STAGE(PG8_SA(0, 1), cA + hstep, voffA);
        if (wr == 1) PG8_BAR;
        PG8_WAIT_V(4); PG8_BAR;
        PG8_STAGE(PG8_SB(1, 0), cB + kstep, voffB); PG8_STAGE(PG8_SA(1, 0), cA + kstep, voffA); PG8_STAGE(PG8_SB(1, 1), cB + hstep + kstep, voffB);
        PG8_WAIT_V(6); PG8_BAR;
    }
    for (;;) {
        const bool has_next = S.next(ui + 1, nxt);
        const char* nA = has_next ? (const char*)g.A + (size_t)nxt.pm * tstep : cA; const char* nB = has_next ? (const char*)g.Bt + (size_t)nxt.pn * tstep : cB;
        for (int t = 0; t < nt; t += 2) {
            const bool last = (t == nt - 2);
            const char* a1 = cA + (size_t)(t + 1) * kstep;
            const char* a2 = last ? nA : cA + (size_t)(t + 2) * kstep; const char* b2 = last ? nB : cB + (size_t)(t + 2) * kstep;
            const char* a3 = a2 + kstep; const char* b3 = b2 + kstep;
            if (last && has_next) S.a_ready(nxt);
            if constexpr (SP2) {
            PG8_LDB(B0, 0, 0); PG8_LDB(B1, 0, 1); PG8_SCHED; PG8_LDA(At, 0, 0); PG8_STAGE(PG8_SA(1, 1), a1 + hstep, voffA);
            PG8_WAIT_V(8); PG8_WAIT_L(0); PG8_BAR; PG8_MMA(0, 0, At, B0); PG8_MMA(0, 1, At, B1); PG8_BAR; PG8_SCHED;
            PG8_LDA(At, 0, 1); PG8_STAGE(PG8_SB(0, 0), b2, voffB); PG8_STAGE(PG8_SB(0, 1), b2 + hstep, voffB); PG8_STAGE(PG8_SA(0, 0), a2, voffA);
            PG8_WAIT_V(8); PG8_WAIT_L(0); PG8_BAR; PG8_MMA(1, 0, At, B0); PG8_MMA(1, 1, At, B1); PG8_BAR; PG8_SCHED;
            PG8_LDB(B0, 1, 0); PG8_LDB(B1, 1, 1); PG8_SCHED; PG8_LDA(At, 1, 0); PG8_STAGE(PG8_SA(0, 1), a2 + hstep, voffA);
            PG8_WAIT_V(8); PG8_WAIT_L(0); PG8_BAR; PG8_MMA(0, 0, At, B0); PG8_MMA(0, 1, At, B1); PG8_BAR; PG8_SCHED;
            PG8_LDA(At, 1, 1); PG8_STAGE(PG8_SB(1, 0), b3, voffB); PG8_STAGE(PG8_SB(1, 1), b3 + hstep, voffB); PG8_STAGE(PG8_SA(1, 0), a3, voffA);
            PG8_WAIT_V(8); PG8_WAIT_L(0); PG8_BAR; PG8_MMA(1, 0, At, B0); PG8_MMA(1, 1, At, B1); PG8_BAR; PG8_SCHED;
            } else {
            PG8_LDB(B0, 0, 0); PG8_SCHED; PG8_LDA(At, 0, 0); PG8_STAGE(PG8_SA(1, 1), a1 + hstep, voffA);
            PG8_WAIT_L(8); PG8_BAR; PG8_WAIT_L(0); PG8_MMA(0, 0, At, B0); PG8_BAR; PG8_SCHED;
            PG8_LDB(B1, 0, 1); PG8_STAGE(PG8_SB(0, 0), b2, voffB);
            PG8_BAR; PG8_WAIT_L(0); PG8_MMA(0, 1, At, B1); PG8_BAR;
            PG8_LDA(At, 0, 1); PG8_STAGE(PG8_SA(0, 0), a2, voffA);
            PG8_BAR; PG8_WAIT_L(0); PG8_MMA(1, 0, At, B0); PG8_BAR; PG8_SCHED;
            PG8_STAGE(PG8_SB(0, 1), b2 + hstep, voffB);
            PG8_WAIT_V(6); PG8_BAR; PG8_MMA(1, 1, At, B1); PG8_BAR;
            PG8_LDB(B0, 1, 0); PG8_SCHED; PG8_LDA(At, 1, 0); PG8_STAGE(PG8_SA(0, 1), a2 + hstep, voffA);
            PG8_WAIT_L(8); PG8_BAR; PG8_WAIT_L(0); PG8_MMA(0, 0, At, B0); PG8_BAR; PG8_SCHED;
            PG8_LDB(B1, 1, 1); PG8_STAGE(PG8_SB(1, 0), b3, voffB);
            PG8_BAR; PG8_WAIT_L(0); PG8_MMA(0, 1, At, B1); PG8_BAR;
            PG8_LDA(At, 1, 1); PG8_STAGE(PG8_SA(1, 0), a3, voffA);
            PG8_BAR; PG8_WAIT_L(0); PG8_MMA(1, 0, At, B0); PG8_BAR; PG8_SCHED;
            PG8_STAGE(PG8_SB(1, 1), b3 + hstep, voffB);
            PG8_WAIT_V(6); PG8_BAR; PG8_MMA(1, 1, At, B1); PG8_BAR;
            }
        }
        if constexpr (ALIGN_EPI) { if (wr == 0) PG8_BAR; }
        if constexpr (!Epi::AFTER_DRAIN) { E(acc, cur, wr, wc, fr, fq); S.done(cur); }
        if (!has_next) break;
#pragma unroll
        for (int a = 0; a < 2; ++a)
#pragma unroll
            for (int b = 0; b < 2; ++b)
#pragma unroll
                for (int m = 0; m < 4; ++m)
#pragma unroll
                    for (int n = 0; n < 2; ++n) acc[a][b][m][n] = (f32x4){0.f, 0.f, 0.f, 0.f};
        cur = nxt; cA = nA; cB = nB; ++ui;
        if constexpr (ALIGN_EPI) { if (wr == 1) PG8_BAR; }
    }
    PG8_WAIT_V(0);
    if constexpr (!ALIGN_EPI) { if (wr == 0) PG8_BAR; }
    PG8_BAR;
    if constexpr (Epi::AFTER_DRAIN) { E.fused(acc, cur, wr, wc, fr, fq, lds, wid, lane); S.done(cur); }
#undef PG8_SA
#undef PG8_SB
#undef PG8_STAGE
#undef PG8_LDA
#undef PG8_LDB
#undef PG8_MMA
#undef PG8_WAIT_V
#undef PG8_WAIT_L
#undef PG8_BAR
#undef PG8_SCHED
}
}
using pg8::bflo; using pg8::bfhi;
#define cvt_pk_bf16_c pg8::cvt_pk_bf16
using pg8::bf16_t; using pg8::bf16x8; using pg8::f32x4; using pg8::u32x4;
#define LAS __attribute__((address_space(3)))
typedef short s16x4 __attribute__((ext_vector_type(4)));
typedef unsigned u32x2 __attribute__((ext_vector_type(2)));

constexpr int NB = 2, SEQ = 16384, T = NB * SEQ, D = 2048, DA = 1024, DB = 1536, DBO = 512, DFF = 8192, INC = 10752, NH = 12;
constexpr float EPS = 1e-6f;
constexpr size_t MiB = 1u << 20;
constexpr size_t WS_MOD = 1 * MiB;
constexpr size_t WS_LSE = 2 * MiB;
constexpr size_t WS_WSB = 4 * MiB;
constexpr size_t WS_VST = 4 * MiB + 512 * 1024;
constexpr size_t WS_W = 5 * MiB;
constexpr size_t WO_IN = 0, WO_OA = 42 * MiB, WO_OB = 46 * MiB, WO_OUT = 48 * MiB, WO_W1 = 56 * MiB, WO_W2 = 88 * MiB;
constexpr size_t WS_H = 125 * MiB;
constexpr size_t WS_BIG = 253 * MiB;
constexpr size_t BO_U = 0, BO_VA = 64 * MiB, BO_Q = 128 * MiB, BO_K = 224 * MiB, BO_V = 320 * MiB, BO_SGA = 416 * MiB, BO_SGB = 544 * MiB;
constexpr size_t WS_L1 = WS_BIG + 672 * MiB;
constexpr size_t WS_END = WS_L1 + 88 * MiB;
constexpr size_t WS_C1 = WS_MOD + 256 * 1024;
constexpr size_t WS_CIN = WS_MOD + 384 * 1024;
constexpr size_t WS_SS = WS_MOD + 512 * 1024;
struct WOff { size_t in, oa, ob, out, w1, w2; };
__device__ __forceinline__ WOff woff(int l) { WOff w;
    w.in = l == 0 ? WS_W + WO_IN : WS_L1; w.oa = l == 0 ? WS_W + WO_OA : WS_L1 + 74 * MiB; w.ob = l == 0 ? WS_W + WO_OB : WS_L1 + 78 * MiB;
    w.out = l == 0 ? WS_W + WO_OUT : WS_L1 + 80 * MiB; w.w1 = l == 0 ? WS_W + WO_W1 : WS_L1 + 42 * MiB; w.w2 = l == 0 ? WS_W + WO_W2 : WS_W + WO_IN; return w; }
constexpr int LDS_BYTES = 135168;
constexpr int NPHASE = 20;

struct Args { const float* in[20]; float* out; unsigned char* ws; };

__device__ __forceinline__ float wave_sum(float v) {
#pragma unroll
    for (int o = 1; o < 64; o <<= 1) v += __shfl_xor(v, o);
    return v;
}
__device__ __forceinline__ unsigned f2bf(float f) { unsigned u = __float_as_uint(f); return (u + 0x7fffu + ((u >> 16) & 1u)) >> 16; }
__device__ __forceinline__ unsigned pk2(float lo, float hi) { return f2bf(lo) | (f2bf(hi) << 16); }
__device__ __forceinline__ unsigned off_b(unsigned row, unsigned ch) { return 256u * row + 16u * (ch ^ (((row & 3u) << 2) | ((row >> 2) & 3u))); }

__device__ __forceinline__ void transpose_item(const float* W, int K, int N, bf16_t* WT, int item, int lane) {
    const int nblk = N / 256, kb = item / nblk, nb = item % nblk, k0 = 16 * kb, n0 = 256 * nb + 4 * lane;
    const float* src = W + (size_t)k0 * N + n0;
    f32x4 v[16];
#pragma unroll
    for (int i = 0; i < 16; ++i) v[i] = __builtin_nontemporal_load((const f32x4*)(src + (size_t)i * N));
#pragma unroll
    for (int c = 0; c < 4; ++c) { bf16_t* dst = WT + (size_t)(n0 + c) * K + k0;
        u32x4 lo, hi;
        lo.x = cvt_pk_bf16_c(v[0][c], v[1][c]); lo.y = cvt_pk_bf16_c(v[2][c], v[3][c]); lo.z = cvt_pk_bf16_c(v[4][c], v[5][c]); lo.w = cvt_pk_bf16_c(v[6][c], v[7][c]);
        hi.x = cvt_pk_bf16_c(v[8][c], v[9][c]); hi.y = cvt_pk_bf16_c(v[10][c], v[11][c]); hi.z = cvt_pk_bf16_c(v[12][c], v[13][c]); hi.w = cvt_pk_bf16_c(v[14][c], v[15][c]);
        *(u32x4*)dst = lo; *(u32x4*)(dst + 8) = hi; }
}
__device__ __forceinline__ void convert_layer_weights(const float* const* inp, unsigned char* ws, int l, LAS unsigned char* lds, int gw, int NGW, int wave, int lane) {
    const WOff wo = woff(l);
    const float* w_in = inp[5] + (size_t)l * D * INC;   const float* w_oa = inp[11] + (size_t)l * DA * D; const float* w_ob = inp[12] + (size_t)l * DBO * D;
    const float* w_out = inp[13] + (size_t)l * D * D;   const float* w1 = inp[15] + (size_t)l * D * DFF;  const float* w2 = inp[17] + (size_t)l * DFF * D;
    constexpr int I_IN = (D / 16) * (INC / 256), I_OA = (DA / 16) * (D / 256), I_OB = (DBO / 16) * (D / 256), I_OUT = (D / 16) * (D / 256), I_1 = (D / 16) * (DFF / 256), I_2 = (DFF / 16) * (D / 256);
    constexpr int NITEMS = I_IN + I_OA + I_OB + I_OUT + I_1 + I_2;
    for (int it = gw; it < NITEMS; it += NGW) {
        int r = it;
        if (r < I_IN) { transpose_item(w_in, D, INC, (bf16_t*)(ws + wo.in), r, lane); continue; } r -= I_IN;
        if (r < I_OA) { transpose_item(w_oa, DA, D, (bf16_t*)(ws + wo.oa), r, lane); continue; } r -= I_OA;
        if (r < I_OB) { transpose_item(w_ob, DBO, D, (bf16_t*)(ws + wo.ob), r, lane); continue; } r -= I_OB;
        if (r < I_OUT) { transpose_item(w_out, D, D, (bf16_t*)(ws + wo.out), r, lane); continue; } r -= I_OUT;
        if (r < I_1) { transpose_item(w1, D, DFF, (bf16_t*)(ws + wo.w1), r, lane); continue; } r -= I_1;
        transpose_item(w2, DFF, D, (bf16_t*)(ws + wo.w2), r, lane);
    }
}
template <bool SILU> __device__ __forceinline__ void gemv_item(const float* W, size_t ldw, const float* x0, const float* x1, const float* bias, float* out0, float* out1, int col0, LAS unsigned char* lds, int tid, int wave, int lane) {
    const int l5 = lane & 31, rg = wave * 2 + (lane >> 5), k0 = rg * 128;
    const float* Wp = W + (size_t)k0 * ldw + col0 + 4 * l5;
    f32x4 a0 = {0.f, 0.f, 0.f, 0.f}, a1 = {0.f, 0.f, 0.f, 0.f};
#pragma unroll 8
    for (int k = 0; k < 128; ++k) {
        const f32x4 w = __builtin_nontemporal_load((const f32x4*)(Wp + (size_t)k * ldw));
        float s0 = x0[k0 + k], s1 = x1[k0 + k];
        if (SILU) { s0 = s0 * __builtin_amdgcn_rcpf(1.0f + __expf(-s0)); s1 = s1 * __builtin_amdgcn_rcpf(1.0f + __expf(-s1)); }
        a0 += w * s0; a1 += w * s1;
    }
    LAS float* red = (LAS float*)lds;
    __syncthreads();
    *(LAS f32x4*)(red + (rg * 2 + 0) * 128 + l5 * 4) = a0;
    *(LAS f32x4*)(red + (rg * 2 + 1) * 128 + l5 * 4) = a1;
    __syncthreads();
    if (tid < 256) { const int b = tid >> 7, col = tid & 127; float sm = 0.f;
#pragma unroll
      for (int w = 0; w < 16; ++w) sm += red[(w * 2 + b) * 128 + col];
      (b ? out1 : out0)[col0 + col] = sm + bias[col0 + col]; }
    __syncthreads();
}
__device__ __forceinline__ void norm_phase(const float* x, const float* g, const float* shift, const float* scale, bf16_t* H, int gw, int NGW, int lane) {
    for (int b = 0; b < NB; ++b) {
        f32x4 ca[4][2], cs[4][2];
#pragma unroll
        for (int j = 0; j < 4; ++j)
#pragma unroll
            for (int h = 0; h < 2; ++h) { const int col = j * 512 + lane * 8 + h * 4;
                const f32x4 gg = *(const f32x4*)(g + col), sc = *(const f32x4*)(scale + b * 12288 + col);
                ca[j][h] = gg * (sc + 1.0f); cs[j][h] = *(const f32x4*)(shift + b * 12288 + col); }
        for (int r = gw; r < SEQ; r += NGW) {
            const float* xr = x + (size_t)(b * SEQ + r) * D;
            f32x4 v[4][2]; float ss = 0.f;
#pragma unroll
            for (int j = 0; j < 4; ++j)
#pragma unroll
                for (int h = 0; h < 2; ++h) { v[j][h] = *(const f32x4*)(xr + j * 512 + lane * 8 + h * 4); const f32x4 q = v[j][h] * v[j][h]; ss += (q[0] + q[1]) + (q[2] + q[3]); }
            const float rstd = 1.0f / sqrtf(wave_sum(ss) * (1.0f / D) + EPS);
            bf16_t* hr = H + (size_t)(b * SEQ + r) * D;
#pragma unroll
            for (int j = 0; j < 4; ++j) { const f32x4 o0 = v[j][0] * rstd * ca[j][0] + cs[j][0], o1 = v[j][1] * rstd * ca[j][1] + cs[j][1];
                u32x4 w; w.x = pk2(o0[0], o0[1]); w.y = pk2(o0[2], o0[3]); w.z = pk2(o1[0], o1[1]); w.w = pk2(o1[2], o1[3]);
                *(u32x4*)(hr + j * 512 + lane * 8) = w; }
        }
    }
}
__device__ __forceinline__ void final_norm_phase(const bf16_t* xb, const float* ssq, float* out, const float* g, int gw, int NGW, int lane) {
    f32x4 cg_[4][2];
#pragma unroll
    for (int j = 0; j < 4; ++j)
#pragma unroll
        for (int h = 0; h < 2; ++h) cg_[j][h] = *(const f32x4*)(g + j * 512 + lane * 8 + h * 4);
    for (int r = gw; r < T; r += NGW) {
        const bf16_t* xr = xb + (size_t)r * D; float* orow = out + (size_t)r * D;
        u32x4 v[4];
#pragma unroll
        for (int j = 0; j < 4; ++j) v[j] = *(const u32x4*)(xr + j * 512 + lane * 8);
        const float rstd = 1.0f / sqrtf(ssq[r] * (1.0f / D) + EPS);
#pragma unroll
        for (int j = 0; j < 4; ++j) { const f32x4 a = {bflo(v[j].x), bfhi(v[j].x), bflo(v[j].y), bfhi(v[j].y)}, b = {bflo(v[j].z), bfhi(v[j].z), bflo(v[j].w), bfhi(v[j].w)};
            *(f32x4*)(orow + j * 512 + lane * 8) = a * rstd * cg_[j][0]; *(f32x4*)(orow + j * 512 + lane * 8 + 4) = b * rstd * cg_[j][1]; }
    }
}
__device__ __forceinline__ s16x4 tr_read(LAS unsigned char* p) { return __builtin_amdgcn_ds_read_tr16_b64_v4i16((LAS s16x4*)p); }
__device__ __forceinline__ void attn_item(bf16_t* Q, const bf16_t* Kg, const bf16_t* Vg, float* lse, int item, int par, bool reuse, LAS unsigned char* lds, int tid, int wave, int lane) {
    const int n = item & 127, bh = item >> 7, h = bh % NH, b = bh / NH, grp = h >> 2;
    const int dsh = 2 * grp, d = 1 << dsh, nbsh = 7 - dsh;
    const int r = n >> nbsh, nblk = n & ((1 << nbsh) - 1);
    const int fr = lane & 15, fq = lane >> 4;
    LAS unsigned char* Kl = lds; LAS unsigned char* Vl = lds + 65536;
    __syncthreads();
    if (!reuse) {
        u32x4 kr[8], vr[8];
#pragma unroll
        for (int i = 0; i < 8; ++i) { const int id = tid + 512 * i, j = id >> 4, ch = id & 15; int mk = (nblk - 1) * 128 + j; mk = mk < 0 ? 0 : mk;
            const size_t go = ((size_t)(b * SEQ + (mk << dsh) + r)) * DB + h * 128 + ch * 8;
            kr[i] = *(const u32x4*)(Kg + go); vr[i] = *(const u32x4*)(Vg + go); }
#pragma unroll
        for (int i = 0; i < 8; ++i) { const int id = tid + 512 * i, j = id >> 4, ch = id & 15; const unsigned o = off_b((j + 128 * par) & 255, ch);
            *(LAS u32x4*)(Kl + o) = kr[i]; *(LAS u32x4*)(Vl + o) = vr[i]; }
    } else {
        u32x4 kr[4], vr[4];
#pragma unroll
        for (int i = 0; i < 4; ++i) { const int id = tid + 512 * i, j = 128 + (id >> 4), ch = id & 15; const int mk = (nblk - 1) * 128 + j;
            const size_t go = ((size_t)(b * SEQ + (mk << dsh) + r)) * DB + h * 128 + ch * 8;
            kr[i] = *(const u32x4*)(Kg + go); vr[i] = *(const u32x4*)(Vg + go); }
#pragma unroll
        for (int i = 0; i < 4; ++i) { const int id = tid + 512 * i, j = 128 + (id >> 4), ch = id & 15; const unsigned o = off_b((j + 128 * par) & 255, ch);
            *(LAS u32x4*)(Kl + o) = kr[i]; *(LAS u32x4*)(Vl + o) = vr[i]; }
    }
    const int qi = 16 * wave + fr;
    const size_t qrow = (size_t)(b * SEQ + (((nblk << 7) + qi) << dsh) + r);
    bf16x8 qf[4];
#pragma unroll
    for (int s = 0; s < 4; ++s) qf[s] = *(const bf16x8*)(Q + qrow * DB + h * 128 + 32 * s + 8 * fq);
    __syncthreads();
    const int T0 = 2 * (wave >> 1);
    const unsigned xk = ((fr & 3) << 2) | ((fr >> 2) & 3);
    f32x4 sacc[10];
#pragma unroll
    for (int kt = 0; kt < 10; ++kt) { sacc[kt] = (f32x4){0.f, 0.f, 0.f, 0.f};
#pragma unroll
        for (int s = 0; s < 4; ++s) { const bf16x8 kf = *(const LAS bf16x8*)(Kl + 4096u * ((T0 + kt + 8 * par) & 15) + 256u * fr + 16u * ((4 * s + fq) ^ xk));
            sacc[kt] = __builtin_amdgcn_mfma_f32_16x16x32_bf16(kf, qf[s], sacc[kt], 0, 0, 0); } }
    const float slope2 = exp2f(-8.0f * (float)(h + 1) / 12.0f) * (float)d * 1.4426950409f;
    const float sc2 = 0.08838834764831845f * 1.4426950409f;
    float mx = -3.0e38f;
    const int dist0 = 128 + qi - 16 * T0 - 4 * fq;
    const unsigned ub = (nblk > 0) ? 128u : (unsigned)qi;
#pragma unroll
    for (int kt = 0; kt < 10; ++kt)
#pragma unroll
        for (int e = 0; e < 4; ++e) { const int dist = dist0 - (16 * kt + e);
            const float s2 = sacc[kt][e] * sc2 - slope2 * (float)dist;
            sacc[kt][e] = ((unsigned)dist <= ub) ? s2 : -3.0e38f; mx = fmaxf(mx, sacc[kt][e]); }
    mx = fmaxf(mx, __shfl_xor(mx, 16)); mx = fmaxf(mx, __shfl_xor(mx, 32));
    float lsum = 0.f;
#pragma unroll
    for (int kt = 0; kt < 10; ++kt)
#pragma unroll
        for (int e = 0; e < 4; ++e) { const float p = __builtin_amdgcn_exp2f(sacc[kt][e] - mx); sacc[kt][e] = p; lsum += p; }
    lsum += __shfl_xor(lsum, 16); lsum += __shfl_xor(lsum, 32);
    bf16x8 pf[5];
#pragma unroll
    for (int ks = 0; ks < 5; ++ks) { u32x4 w; w.x = cvt_pk_bf16_c(sacc[2 * ks][0], sacc[2 * ks][1]); w.y = cvt_pk_bf16_c(sacc[2 * ks][2], sacc[2 * ks][3]);
        w.z = cvt_pk_bf16_c(sacc[2 * ks + 1][0], sacc[2 * ks + 1][1]); w.w = cvt_pk_bf16_c(sacc[2 * ks + 1][2], sacc[2 * ks + 1][3]); pf[ks] = __builtin_bit_cast(bf16x8, w); }
    const int q4 = fr >> 2, p4 = fr & 3;
    const unsigned xv = (q4 << 2) | fq;
    LAS unsigned char* vbase = Vl + 256u * (4 * fq + q4) + 8u * (p4 & 1);
    f32x4 oacc[8];
    const float inv = 1.0f / lsum;
    bf16_t* orow = Q + qrow * DB + h * 128 + 4 * fq;
#pragma unroll
    for (int c = 0; c < 8; ++c) { oacc[c] = (f32x4){0.f, 0.f, 0.f, 0.f};
        const unsigned co = 16u * ((2 * c + (p4 >> 1)) ^ xv);
#pragma unroll
        for (int ks = 0; ks < 5; ++ks) { const s16x4 lo = tr_read(vbase + co + 4096u * ((T0 + 2 * ks + 8 * par) & 15)), hi = tr_read(vbase + co + 4096u * ((T0 + 2 * ks + 1 + 8 * par) & 15));
            const bf16x8 vf = __builtin_shufflevector(lo, hi, 0, 1, 2, 3, 4, 5, 6, 7);
            oacc[c] = __builtin_amdgcn_mfma_f32_16x16x32_bf16(vf, pf[ks], oacc[c], 0, 0, 0); }
        u32x2 w; w.x = cvt_pk_bf16_c(oacc[c][0] * inv, oacc[c][1] * inv); w.y = cvt_pk_bf16_c(oacc[c][2] * inv, oacc[c][3] * inv);
        *(u32x2*)(orow + 16 * c) = w; }
    if (fq == 0) lse[qrow * NH + h] = (mx + __builtin_amdgcn_logf(lsum)) * 0.6931471805599453f;
}
__device__ __forceinline__ void gate_item(bf16_t* U, const bf16_t* VA, const bf16_t* WsB, const float* gv, const float* bv, const float* bs, const float* vst, int chunk, LAS unsigned char* lds, int tid, int wave, int lane) {
    const int fr = lane & 15, fq = lane >> 4;
    LAS unsigned char* Vi = lds; LAS unsigned char* Wi = lds + 32768; LAS float* st = (LAS float*)(lds + 65536);
    __syncthreads();
    if (tid < 128) { const float s1 = vst[2 * (size_t)(chunk * 128 + tid)], s2 = vst[2 * (size_t)(chunk * 128 + tid) + 1];
        const float mean = s1 * (1.0f / DA), var = fmaxf(s2 * (1.0f / DA) - mean * mean, 0.f);
        st[2 * tid] = mean; st[2 * tid + 1] = 1.0f / sqrtf(var + EPS); }
    const int ch = tid & 15, s0 = tid >> 4, q4 = fr >> 2, p4 = fr & 3;
    u32x4 pv[4], pw[4]; f32x4 g0, g1, b0, b1;
#define GATE_LOAD(g) do { _Pragma("unroll") for (int i = 0; i < 4; ++i) { pv[i] = *(const u32x4*)(VA + (size_t)(chunk * 128 + s0 + 32 * i) * DA + (g) * 128 + ch * 8); pw[i] = *(const u32x4*)(WsB + (size_t)((g) * 128 + s0 + 32 * i) * 128 + ch * 8); } \
        g0 = *(const f32x4*)(gv + (g) * 128 + ch * 8); g1 = *(const f32x4*)(gv + (g) * 128 + ch * 8 + 4); b0 = *(const f32x4*)(bv + (g) * 128 + ch * 8); b1 = *(const f32x4*)(bv + (g) * 128 + ch * 8 + 4); } while (0)
    GATE_LOAD(0);
#pragma unroll 1
    for (int g = 0; g < 8; ++g) {
        __syncthreads();
#pragma unroll
        for (int i = 0; i < 4; ++i) { const int s = s0 + 32 * i; const u32x4 a = pv[i];
            const float mean = st[2 * s], rstd = st[2 * s + 1];
            u32x4 w; w.x = cvt_pk_bf16_c((bflo(a.x) - mean) * rstd * g0[0] + b0[0], (bfhi(a.x) - mean) * rstd * g0[1] + b0[1]); w.y = cvt_pk_bf16_c((bflo(a.y) - mean) * rstd * g0[2] + b0[2], (bfhi(a.y) - mean) * rstd * g0[3] + b0[3]);
            w.z = cvt_pk_bf16_c((bflo(a.z) - mean) * rstd * g1[0] + b1[0], (bfhi(a.z) - mean) * rstd * g1[1] + b1[1]); w.w = cvt_pk_bf16_c((bflo(a.w) - mean) * rstd * g1[2] + b1[2], (bfhi(a.w) - mean) * rstd * g1[3] + b1[3]);
            *(LAS u32x4*)(Vi + off_b(s, ch)) = w;
            *(LAS u32x4*)(Wi + off_b(s, ch)) = pw[i]; }
        if (g < 7) GATE_LOAD(g + 1);
        const float bsv = bs[g * 128 + 16 * wave + fr];
        bf16_t* ur = U + (size_t)(chunk * 128 + 16 * wave + fr) * DA + g * 128 + 4 * fq;
        u32x2 uu[8];
#pragma unroll
        for (int c = 0; c < 8; ++c) uu[c] = *(const u32x2*)(ur + 16 * c);
        __syncthreads();
        f32x4 acc[8];
#pragma unroll
        for (int c = 0; c < 8; ++c) acc[c] = (f32x4){0.f, 0.f, 0.f, 0.f};
#pragma unroll 1
        for (int ks = 0; ks <= (wave >> 1); ++ks) {
            const bf16x8 wf = *(const LAS bf16x8*)(Wi + off_b(16 * wave + fr, 4 * ks + fq));
#pragma unroll
            for (int c = 0; c < 8; ++c) {
                const s16x4 lo = tr_read(Vi + off_b(32 * ks + 8 * fq + q4, 2 * c + (p4 >> 1)) + 8 * (p4 & 1)), hi = tr_read(Vi + off_b(32 * ks + 8 * fq + 4 + q4, 2 * c + (p4 >> 1)) + 8 * (p4 & 1));
                const bf16x8 vf = __builtin_shufflevector(lo, hi, 0, 1, 2, 3, 4, 5, 6, 7);
                acc[c] = __builtin_amdgcn_mfma_f32_16x16x32_bf16(vf, wf, acc[c], 0, 0, 0); } }
#pragma unroll
        for (int c = 0; c < 8; ++c) { const u32x2 u2 = uu[c];
            u32x2 w; w.x = cvt_pk_bf16_c(bflo(u2.x) * (acc[c][0] + bsv), bfhi(u2.x) * (acc[c][1] + bsv)); w.y = cvt_pk_bf16_c(bflo(u2.y) * (acc[c][2] + bsv), bfhi(u2.y) * (acc[c][3] + bsv));
            *(u32x2*)(ur + 16 * c) = w; }
    }
#undef GATE_LOAD
}
__device__ __forceinline__ void combine_phase(const bf16_t* O, const float* lse, bf16_t* YB, int gw, int NGW, int lane) {
    const int hg = lane >> 4, c8 = (lane & 15) * 8;
    for (int t = gw; t < T; t += NGW) {
        const float l0 = lse[(size_t)t * NH + hg], l1 = lse[(size_t)t * NH + 4 + hg], l2 = lse[(size_t)t * NH + 8 + hg];
        const float m = fmaxf(l0, fmaxf(l1, l2)); float w0 = __expf(l0 - m), w1 = __expf(l1 - m), w2 = __expf(l2 - m); const float inv = 1.0f / (w0 + w1 + w2); w0 *= inv; w1 *= inv; w2 *= inv;
        const bf16_t* op = O + (size_t)t * DB + hg * 128 + c8;
        const u32x4 a = *(const u32x4*)op, b = *(const u32x4*)(op + 512), c = *(const u32x4*)(op + 1024);
        u32x4 w;
        w.x = pk2(w0 * bflo(a.x) + w1 * bflo(b.x) + w2 * bflo(c.x), w0 * bfhi(a.x) + w1 * bfhi(b.x) + w2 * bfhi(c.x));
        w.y = pk2(w0 * bflo(a.y) + w1 * bflo(b.y) + w2 * bflo(c.y), w0 * bfhi(a.y) + w1 * bfhi(b.y) + w2 * bfhi(c.y));
        w.z = pk2(w0 * bflo(a.z) + w1 * bflo(b.z) + w2 * bflo(c.z), w0 * bfhi(a.z) + w1 * bfhi(b.z) + w2 * bfhi(c.z));
        w.w = pk2(w0 * bflo(a.w) + w1 * bflo(b.w) + w2 * bflo(c.w), w0 * bfhi(a.w) + w1 * bfhi(b.w) + w2 * bfhi(c.w));
        *(u32x4*)(YB + (size_t)t * DBO + hg * 128 + c8) = w;
    }
}

#define XB_TMO      128
#define XB_XCNT(j)  (256  + 64 * (j))
#define XB_XSUB(j)  (1280 + 64 * (j))
#define XB_XGEN(j)  (2304 + 64 * (j))
#define XB_TOP      3328
#define XB_TOPGEN   3392
#define XCD_BAR_WORDS 3456
#define XB_SPIN_CAP (1u << 18)

__device__ __forceinline__ unsigned xb_ld(unsigned* p)              { return __hip_atomic_load(p, __ATOMIC_RELAXED, __HIP_MEMORY_SCOPE_AGENT); }
__device__ __forceinline__ unsigned xb_add(unsigned* p, unsigned v) { return __hip_atomic_fetch_add(p, v, __ATOMIC_RELAXED, __HIP_MEMORY_SCOPE_AGENT); }
__device__ __forceinline__ unsigned xb_xcc_id() { return (unsigned)__builtin_amdgcn_s_getreg((3 << 11) | 20) & 0xFu; }
#define XB_SPIN(cond, bar) do { unsigned _sp = 0; while (cond) { __builtin_amdgcn_s_sleep(1); \
    if ((++_sp & 255u) == 0u) { if (xb_ld(&(bar)[XB_TMO])) break; if (_sp > XB_SPIN_CAP) { atomicAdd(&(bar)[XB_TMO], 1u); break; } } } } while (0)

struct XcdBarrier {
    unsigned* bar; unsigned x;
    volatile LAS unsigned* st;
};

__device__ __forceinline__ XcdBarrier xcd_barrier_post(unsigned* bar, volatile LAS unsigned* st) {
    XcdBarrier b; b.bar = bar; b.x = xb_xcc_id(); b.st = st;
    if (threadIdx.x == 0) (void)xb_add(&bar[XB_XCNT(b.x)], 1u);
    return b;
}
__device__ __forceinline__ void xcd_barrier_complete(unsigned* bar, unsigned x, unsigned& nloc, unsigned& nx) {
    const unsigned G = gridDim.x * gridDim.y * gridDim.z;
    unsigned sum, cnt, mine, sp = 0u;
    for (;;) {
        sum = 0u; cnt = 0u; mine = 0u;
#pragma unroll
        for (unsigned j = 0; j < 16; ++j) { const unsigned c = xb_ld(&bar[XB_XCNT(j)]); sum += c; cnt += (c > 0u) ? 1u : 0u; mine = (j == x) ? c : mine; }
        if (sum == G) break;
        __builtin_amdgcn_s_sleep(1);
        if ((++sp & 255u) == 0u) { if (xb_ld(&bar[XB_TMO])) break; if (sp > XB_SPIN_CAP) { atomicAdd(&bar[XB_TMO], 1u); break; } }
    }
    nloc = mine > 0u ? mine : 1u; nx = cnt > 0u ? cnt : 1u;
}

__device__ __forceinline__ void xcd_barrier(const XcdBarrier& b) {
    asm volatile("s_waitcnt vmcnt(0)" ::: "memory");
    __syncthreads();
    if (threadIdx.x == 0) {
        unsigned* bar = b.bar;
        __builtin_amdgcn_s_waitcnt(0);
        unsigned nloc = b.st[0], nx = b.st[1];
        if (nloc == 0u) { xcd_barrier_complete(bar, b.x, nloc, nx); b.st[0] = nloc; b.st[1] = nx; }
        const unsigned old = xb_add(&bar[XB_XSUB(b.x)], 1u);
        const unsigned gen = old / nloc;
        if (old + 1u == (gen + 1u) * nloc) {
            __builtin_amdgcn_fence(__ATOMIC_RELEASE, "agent");
            asm volatile("s_waitcnt vmcnt(0)" ::: "memory");
            const unsigned og = xb_add(&bar[XB_TOP], 1u);
            const unsigned tg = og / nx;
            if (og + 1u == (tg + 1u) * nx) xb_add(&bar[XB_TOPGEN], 1u);
            else XB_SPIN(xb_ld(&bar[XB_TOPGEN]) == tg, bar);
            __builtin_amdgcn_fence(__ATOMIC_ACQUIRE, "agent");
            xb_add(&bar[XB_XGEN(b.x)], 1u);
            asm volatile("s_waitcnt vmcnt(0)" ::: "memory");
        } else {
            XB_SPIN(xb_ld(&bar[XB_XGEN(b.x)]) == gen, bar);
            __builtin_amdgcn_fence(__ATOMIC_ACQUIRE, "agent");
            asm volatile("s_waitcnt vmcnt(0)" ::: "memory");
        }
    }
    __syncthreads();
}

#define CG_SYNC() do { asm volatile("s_waitcnt vmcnt(0)" ::: "memory");     \
    cg::this_grid().sync(); \
    __builtin_amdgcn_fence(__ATOMIC_ACQUIRE, "agent");                        \
    asm volatile("s_waitcnt vmcnt(0)" ::: "memory"); } while (0)
#define GRID_SYNC() do { XcdBarrier xb_; xb_.bar = (unsigned*)args.ws; xb_.x = xb_xcc_id(); xb_.st = (volatile LAS unsigned*)(lds + 131072 + 64); xcd_barrier(xb_); } while (0)
#define PHASE_VARS \
    int tid = threadIdx.x; asm volatile("" : "+v"(tid)); \
    const int lane = tid & 63, wave = __builtin_amdgcn_readfirstlane(tid >> 6), gw = bx * 8 + wave; (void)lane; (void)gw; \
    const float* const* inp = (const float* const*)__builtin_amdgcn_kernarg_segment_ptr(); asm volatile("" : "+s"(inp));     \
    unsigned char* ws = args.ws; asm volatile("" : "+s"(ws)); \
    float* xo = args.out; asm volatile("" : "+s"(xo)); (void)xo; bf16_t* XB = (bf16_t*)xo; (void)XB;     \
    float* mod = (float*)(ws + WS_MOD); float* lse = (float*)(ws + WS_LSE); bf16_t* WsB = (bf16_t*)(ws + WS_WSB); (void)mod; (void)lse; (void)WsB; \
    bf16_t* Wb = (bf16_t*)(ws + WS_W); bf16_t* H = (bf16_t*)(ws + WS_H); unsigned char* big = ws + WS_BIG; (void)Wb; (void)H; \
    bf16_t *U = (bf16_t*)(big + BO_U), *VA = (bf16_t*)(big + BO_VA), *Qb = (bf16_t*)(big + BO_Q), *Kb = (bf16_t*)(big + BO_K), *Vb = (bf16_t*)(big + BO_V), *SGA = (bf16_t*)(big + BO_SGA), *SGB = (bf16_t*)(big + BO_SGB); \
    (void)U; (void)VA; (void)Qb; (void)Kb; (void)Vb; (void)SGA; (void)SGB; \
    bf16_t* MRG = Kb; bf16_t* HID = (bf16_t*)big; bf16_t* YB = H; (void)MRG; (void)HID; (void)YB;
#define WPTR(off) ((const bf16_t*)((unsigned char*)Wb + (off)))

template <int L> __device__ __forceinline__ void layer_phases(const Args& args, LAS unsigned char* lds, const int G, const int bx, const int NGW) {
    constexpr int l = L;
    if (l == 0) {
        { PHASE_VARS
          for (int it = bx; it < 212; it += G) {
              if (it < 128) { const int ll = it >> 6, cb = it & 63; const float* sh = mod + (size_t)ll * 2 * 12288 + 3 * D; float* c1 = (float*)(ws + WS_C1) + (size_t)ll * 2 * 8192;
                  gemv_item<false>(inp[15] + (size_t)ll * D * DFF, DFF, sh, sh + 12288, inp[16] + (size_t)ll * DFF, c1, c1 + 8192, cb * 128, lds, tid, wave, lane); }
              else { const int cb = it - 128; const float* sh = mod + (size_t)2 * 12288; float* cin = (float*)(ws + WS_CIN);
                  gemv_item<false>(inp[5] + (size_t)D * INC, INC, sh, sh + 12288, inp[6] + INC, cin, cin + INC, cb * 128, lds, tid, wave, lane); } }
          norm_phase(inp[0], inp[4], mod + 0 * D, mod + 1 * D, H, gw, NGW, lane); }
        GRID_SYNC();
    }
    for (int rep = 0; rep < 1 + ((REP_MASK >> 2) & 1); ++rep) {
    { PHASE_VARS const WOff wo = woff(l); pg8::Gemm g{H, (const bf16_t*)(ws + wo.in), T, INC, D}; pg8::StaticOrder S; S.init(T, INC, G, bx);
      pg8::EpiInProj E{U, VA, Qb, Kb, Vb, SGA, SGB, l == 0 ? inp[6] : (const float*)(ws + WS_CIN), l == 0 ? 0 : INC, l == 0 ? nullptr : (const float*)(ws + WS_SS) + T, (float*)(ws + WS_VST) + (size_t)l * 2 * T};
      pg8::gemm_phase<pg8::EpiInProj, pg8::StaticOrder, true, true>(lds, g, S, E); }
    GRID_SYNC(); }
    { PHASE_VARS
      { const int per = (NB * NH * 128 + G - 1) / G; int par = 0, prev_bh = -1;
        for (int k = 0; k < per; ++k) { const int it = bx * per + k; if (it >= NB * NH * 128) break;
            const int bh = it >> 7; const bool reuse = (k > 0) && (bh == prev_bh); par = reuse ? (par ^ 1) : 0; prev_bh = bh;
            attn_item(Qb, Kb, Vb, lse, it, par, reuse, lds, tid, wave, lane); } }
      for (int it = bx; it < T / 128; it += G) gate_item(U, VA, WsB + (size_t)l * 8 * 128 * 128, inp[7] + l * DA, inp[8] + l * DA, inp[10] + l * 8 * 128, (const float*)(ws + WS_VST) + (size_t)l * 2 * T, it, lds, tid, wave, lane); }
    GRID_SYNC();
    { PHASE_VARS combine_phase(Qb, lse, YB, gw, NGW, lane);
      if (l == 0) convert_layer_weights(inp, ws, 1, lds, gw, NGW, wave, lane); }
    GRID_SYNC();
    for (int rep = 0; rep < 1 + ((REP_MASK >> 5) & 1); ++rep) {
    { PHASE_VARS const WOff wo = woff(l); pg8::Gemm g{U, (const bf16_t*)(ws + wo.oa), T, D, DA}; pg8::StaticOrder S; S.init(T, D, G, bx);
      pg8::EpiMerge<1> E{MRG, SGA};
      pg8::gemm_phase<pg8::EpiMerge<1>, pg8::StaticOrder, true, true>(lds, g, S, E); }
    { PHASE_VARS const WOff wo = woff(l); pg8::Gemm g{YB, (const bf16_t*)(ws + wo.ob), T, D, DBO}; pg8::StaticOrder S; S.init(T, D, G, bx);
      pg8::EpiMerge<2> E{MRG, SGB};
      pg8::gemm_phase<pg8::EpiMerge<2>, pg8::StaticOrder, true, true>(lds, g, S, E); }
    GRID_SYNC(); }
    {
    { PHASE_VARS const WOff wo = woff(l); const float* modl = mod + (size_t)l * 2 * 12288; const float* xin = (l == 0) ? inp[0] : xo;
      pg8::Gemm g{MRG, (const bf16_t*)(ws + wo.out), T, D, D}; pg8::StaticOrder S; S.init(T, D, G, bx);
      if (l == 0) { pg8::EpiResid<0> E{inp[0], nullptr, XB, modl + 2 * D, nullptr, H, inp[14] + l * D, modl + 4 * D, (float*)(ws + WS_SS) + (size_t)(2 * l) * T};
          pg8::gemm_phase<pg8::EpiResid<0>, pg8::StaticOrder, true, true>(lds, g, S, E); }
      else { pg8::EpiResid<1> E{nullptr, XB, XB, modl + 2 * D, nullptr, H, inp[14] + l * D, modl + 4 * D, (float*)(ws + WS_SS) + (size_t)(2 * l) * T};
          pg8::gemm_phase<pg8::EpiResid<1>, pg8::StaticOrder, true, true>(lds, g, S, E); } }
    GRID_SYNC(); }
    for (int rep = 0; rep < 1 + ((REP_MASK >> 8) & 1); ++rep) {
    { PHASE_VARS const WOff wo = woff(l); pg8::Gemm g{H, (const bf16_t*)(ws + wo.w1), T, DFF, D}; pg8::StaticOrder S; S.init(T, DFF, G, bx);
      pg8::EpiMlp1 E{HID, (const float*)(ws + WS_C1) + (size_t)l * 2 * 8192, (const float*)(ws + WS_SS) + (size_t)(2 * l) * T};
      pg8::gemm_phase<pg8::EpiMlp1, pg8::StaticOrder, true, true>(lds, g, S, E); }
    GRID_SYNC(); }
    {
    { PHASE_VARS const WOff wo = woff(l); const float* modl = mod + (size_t)l * 2 * 12288;
      pg8::Gemm g{HID, (const bf16_t*)(ws + wo.w2), T, D, DFF}; pg8::StaticOrder S; S.init(T, D, G, bx);
      if (l == 0) { pg8::EpiResid<1> E{nullptr, XB, XB, modl + 5 * D, inp[18] + (size_t)l * D, H, inp[4] + D, mod + (size_t)2 * 12288 + 1 * D, (float*)(ws + WS_SS) + T};
          pg8::gemm_phase<pg8::EpiResid<1>, pg8::StaticOrder, true, true>(lds, g, S, E); }
      else { pg8::EpiResid<2> E{nullptr, XB, H, modl + 5 * D, inp[18] + (size_t)l * D, nullptr, nullptr, nullptr, (float*)(ws + WS_SS) + (size_t)3 * T};
          pg8::gemm_phase<pg8::EpiResid<2>, pg8::StaticOrder, true, true>(lds, g, S, E); } }
    GRID_SYNC(); }
}

__global__ void __launch_bounds__(512, 2) fwd_kernel(Args args) {
    extern __shared__ __attribute__((aligned(16))) unsigned char lds_raw[];
    LAS unsigned char* lds = (LAS unsigned char*)lds_raw;
    const int G = gridDim.x, bx = blockIdx.x, NGW = G * 8;
    if (threadIdx.x < 64) ((volatile LAS unsigned*)(lds + 131072))[threadIdx.x] = 0u;
    __syncthreads();
    (void)xcd_barrier_post((unsigned*)args.ws, (volatile LAS unsigned*)(lds + 131072 + 64));
    { PHASE_VARS
      for (int i = bx * 512 + tid; i < 2 * 8 * 128 * 128; i += G * 512) { const int s = i & 127, t = (i >> 7) & 127; WsB[i] = (bf16_t)f2bf(s <= t ? inp[9][i] : 0.f); }
      for (int i = bx * 512 + tid; i < 4 * T; i += G * 512) ((float*)(ws + WS_SS))[i] = 0.f;
      for (int i = bx * 512 + tid; i < 4 * T; i += G * 512) ((float*)(ws + WS_VST))[i] = 0.f;
      for (int it = bx; it < 192; it += G) { const int ll = it / 96, cb = it % 96;
        gemv_item<true>(inp[2] + (size_t)ll * D * 12288, 12288, inp[1], inp[1] + D, inp[3] + (size_t)ll * 12288, mod + (size_t)(ll * 2) * 12288, mod + (size_t)(ll * 2 + 1) * 12288, cb * 128, lds, tid, wave, lane); }
      convert_layer_weights(inp, ws, 0, lds, gw, NGW, wave, lane); }
    if (G > 65536) CG_SYNC();
    GRID_SYNC();
    for (int i = 0; i < EXTRA_SYNCS; ++i) GRID_SYNC();
    layer_phases<0>(args, lds, G, bx, NGW);
    layer_phases<1>(args, lds, G, bx, NGW);
    { PHASE_VARS final_norm_phase(H, (const float*)(ws + WS_SS) + (size_t)3 * T, xo, inp[19], gw, NGW, lane); }
}

extern "C" void kernel_launch(void* const* d_in, const int* in_sizes, int n_in, void* d_out, int out_size, void* d_ws, size_t ws_size, hipStream_t stream) {
    static int grid = 0;
    if (grid == 0) {
        if (n_in != 20 || ws_size < WS_END || out_size != T * D) { fprintf(stderr, "kernel_launch: unexpected problem (n_in %d, ws %zu, out %d)\n", n_in, ws_size, out_size); grid = -1; return; }
        int dev = 0, cus = 0, per_cu = 0;
        hipGetDevice(&dev); hipDeviceGetAttribute(&cus, hipDeviceAttributeMultiprocessorCount, dev);
        if (hipFuncSetAttribute((const void*)fwd_kernel, hipFuncAttributeMaxDynamicSharedMemorySize, LDS_BYTES) != hipSuccess) { fprintf(stderr, "hipFuncSetAttribute failed\n"); grid = -1; return; }
        hipOccupancyMaxActiveBlocksPerMultiprocessor(&per_cu, (const void*)fwd_kernel, 512, LDS_BYTES);
        if (per_cu < 1) { fprintf(stderr, "occupancy query says %d\n", per_cu); per_cu = 1; }
        (void)hipGetLastError();
        grid = cus * 1;
    }
    if (grid < 0) return;
    if (hipMemsetAsync(d_ws, 0, 16384, stream) != hipSuccess) { fprintf(stderr, "memset failed\n"); return; }
    Args a{};
    for (int i = 0; i < 20; ++i) a.in[i] = (const float*)d_in[i];
    a.out = (float*)d_out; a.ws = (unsigned char*)d_ws;
    void* kargs[] = {&a};
    hipError_t e = hipLaunchCooperativeKernel((const void*)fwd_kernel, dim3(grid), dim3(512), kargs, LDS_BYTES, stream);
    if (e != hipSuccess) fprintf(stderr, "cooperative launch failed: %s (grid %d)\n", hipGetErrorString(e), grid);
}
```

```cpp
#include <hip/hip_runtime.h>
#include <hip/hip_cooperative_groups.h>
#include <cstdio>
#include <cstdint>
namespace cg = cooperative_groups;
#ifndef PHMASK
#define PHMASK 0xFFFFF
#endif
#define PHON(k) ((PHMASK >> (k)) & 1)
#ifndef DBG
#define DBG 0
#endif
#ifndef REP_MASK
#define REP_MASK 0
#endif
#ifndef PAIR_REP
#define PAIR_REP 0
#endif
#ifndef REP_DUMMY
#define REP_DUMMY 0
#endif
#ifndef EXTRA_SYNCS
#define EXTRA_SYNCS 0
#endif
#ifndef ONE_LAUNCH
#define ONE_LAUNCH 1
#endif
namespace pg8 {
#define PG8_LAS __attribute__((address_space(3)))
typedef unsigned short bf16_t;
typedef short bf16x8 __attribute__((ext_vector_type(8)));
typedef float f32x4 __attribute__((ext_vector_type(4)));
typedef unsigned u32x4 __attribute__((ext_vector_type(4)));
typedef unsigned u32x2 __attribute__((ext_vector_type(2)));
constexpr int BM = 256, BK = 64, HALF = 128, HTB = HALF * BK * 2  , STAGE_BYTES = 8 * HTB, NXCD = 8, WGM = 4;

__host__ __device__ __forceinline__ int lds_byte(int r, int c) { const int st = (r >> 4) * 2 + (c >> 5), rr = r & 15, cc = c & 31, ob = rr * 64 + cc * 2; return st * 1024 + (ob ^ (((ob >> 9) & 1) << 5)); }
__host__ __device__ __forceinline__ void stage_rc(int b, int& R, int& C) { const int st = b / 1024, sb = b % 1024, swz = sb ^ (((sb >> 9) & 1) << 5); R = (st >> 1) * 16 + swz / 64; C = (st & 1) * 32 + (swz % 64) / 2; }
__host__ __device__ __forceinline__ int perm32(int rho) { const int n = rho >> 4, i = rho & 15; return 8 * (i >> 2) + 4 * n + (i & 3); }

struct Unit { int pm, pn; };
struct Gemm { const bf16_t* A; const bf16_t* Bt; int M, N, K; };

struct StaticOrder {
    int nM, nN, nwg, G, c;
    __host__ __device__ void init(int M, int N, int G_, int c_) { nM = M / BM; nN = N / BM; nwg = nM * nN; G = G_; c = c_; }
    __host__ __device__ bool next(int i, Unit& u) const {
        const long L = (long)i * G + c; if (L >= nwg) return false;
        int wgid = (int)L; { const int q = nwg / NXCD, r = nwg % NXCD, xcd = wgid % NXCD, off = wgid / NXCD; wgid = (xcd < r ? xcd * (q + 1) : r * (q + 1) + (xcd - r) * q) + off; }
        const int nig = WGM * nN, gid = wgid / nig, fm = gid * WGM, gsz = (nM - fm) < WGM ? (nM - fm) : WGM;
        u.pm = fm + ((wgid % nig) % gsz); u.pn = (wgid % nig) / gsz; return true;
    }
    __device__ __forceinline__ void a_ready(const Unit&) const {}
    __device__ __forceinline__ void done(const Unit&) const {}
};
typedef __bf16 bf2_t __attribute__((ext_vector_type(2)));
typedef float f2_t __attribute__((ext_vector_type(2)));
__device__ __forceinline__ unsigned cvt_pk_bf16(float lo, float hi) { return __builtin_bit_cast(unsigned, __builtin_convertvector((f2_t){lo, hi}, bf2_t)); }
__device__ __forceinline__ float bflo(unsigned u) { return __uint_as_float(u << 16); }
__device__ __forceinline__ float bfhi(unsigned u) { return __uint_as_float(u & 0xffff0000u); }
__device__ __forceinline__ float act_gelu(float x) {
    const float e = __builtin_amdgcn_exp2f(x * (-2.302208198f - 0.1029432315f * x * x));
    return x * __builtin_amdgcn_rcpf(1.0f + e);
}
__device__ __forceinline__ float act_sigmoid(float x) { return __builtin_amdgcn_rcpf(1.0f + __builtin_amdgcn_exp2f(-1.4426950409f * x)); }

struct EpiInProj {
    static constexpr bool PERM = true, AFTER_DRAIN = false;
    bf16_t *U, *VA, *Q, *KK, *VV, *SGA, *SGB; const float* bias; int bstride; const float* ss;
    float* vst;
    template <int ACT, bool STATS> __device__ __forceinline__ void run(const f32x4 (&acc)[2][2][4][2], bf16_t* base, int ldc, int row0, int col0, int bcol0) const {
        f32x4 bv[2][2]; const float* bias = this->bias + (size_t)(row0 >> 14) * bstride;
#pragma unroll
        for (int bj = 0; bj < 2; ++bj)
#pragma unroll
            for (int n = 0; n < 2; ++n) bv[bj][n] = *(const f32x4*)(bias + bcol0 + bj * HALF + 4 * n);
#pragma unroll
        for (int ai = 0; ai < 2; ++ai)
#pragma unroll
            for (int m = 0; m < 4; ++m) { const int row = row0 + ai * HALF + m * 16; bf16_t* rowp = base + (size_t)row * ldc + col0;
                const float rs = ss ? __builtin_amdgcn_rsqf(ss[row] * (1.0f / 2048.0f) + 1e-6f) : 1.0f; float s1 = 0.f, s2 = 0.f;
#pragma unroll
                for (int bj = 0; bj < 2; ++bj) { f32x4 v0 = acc[ai][bj][m][0] * rs + bv[bj][0], v1 = acc[ai][bj][m][1] * rs + bv[bj][1];
                    if (ACT == 1) {
#pragma unroll
                        for (int j = 0; j < 4; ++j) { v0[j] = act_gelu(v0[j]); v1[j] = act_gelu(v1[j]); } }
                    if (ACT == 2) {
#pragma unroll
                        for (int j = 0; j < 4; ++j) { v0[j] = act_sigmoid(v0[j]); v1[j] = act_sigmoid(v1[j]); } }
                    if (STATS) { s1 += ((v0[0] + v0[1]) + (v0[2] + v0[3])) + ((v1[0] + v1[1]) + (v1[2] + v1[3])); const f32x4 q0 = v0 * v0, q1 = v1 * v1; s2 += ((q0[0] + q0[1]) + (q0[2] + q0[3])) + ((q1[0] + q1[1]) + (q1[2] + q1[3])); }
                    if (ACT == 2) {
                        const unsigned lo = (unsigned)__builtin_rintf(v0[0] * 255.f) | ((unsigned)__builtin_rintf(v0[1] * 255.f) << 8) | ((unsigned)__builtin_rintf(v0[2] * 255.f) << 16) | ((unsigned)__builtin_rintf(v0[3] * 255.f) << 24);
                        const unsigned hi = (unsigned)__builtin_rintf(v1[0] * 255.f) | ((unsigned)__builtin_rintf(v1[1] * 255.f) << 8) | ((unsigned)__builtin_rintf(v1[2] * 255.f) << 16) | ((unsigned)__builtin_rintf(v1[3] * 255.f) << 24);
                        u32x2 w8; w8.x = lo; w8.y = hi; *(u32x2*)((unsigned char*)base + (size_t)row * ldc + col0 + bj * HALF) = w8; continue; }
                    u32x4 w; w.x = cvt_pk_bf16(v0[0], v0[1]); w.y = cvt_pk_bf16(v0[2], v0[3]); w.z = cvt_pk_bf16(v1[0], v1[1]); w.w = cvt_pk_bf16(v1[2], v1[3]);
                    *(u32x4*)(rowp + bj * HALF) = w; }
                if (STATS) { s1 += __shfl_xor(s1, 16); s1 += __shfl_xor(s1, 32); s2 += __shfl_xor(s2, 16); s2 += __shfl_xor(s2, 32); if ((threadIdx.x & 48) == 0) { atomicAdd(vst + 2 * (size_t)row, s1); atomicAdd(vst + 2 * (size_t)row + 1, s2); } } }
    }
    __device__ __forceinline__ void operator()(const f32x4 (&acc)[2][2][4][2], const Unit& u, int wr, int wc, int fr, int fq) const {
        const int row0 = u.pm * BM + wr * 64 + fr, colt = u.pn * BM, lc = wc * 32 + 8 * fq, bcol0 = colt + lc;
        if (colt < 1024) run<1, false>(acc, U, 1024, row0, colt + lc, bcol0);
        else if (colt < 2048) run<1, true>(acc, VA, 1024, row0, colt - 1024 + lc, bcol0);
        else if (colt < 3584) run<0, false>(acc, Q, 1536, row0, colt - 2048 + lc, bcol0);
        else if (colt < 5120) run<0, false>(acc, KK, 1536, row0, colt - 3584 + lc, bcol0);
        else if (colt < 6656) run<0, false>(acc, VV, 1536, row0, colt - 5120 + lc, bcol0);
        else if (colt < 8704) run<2, false>(acc, SGA, 2048, row0, colt - 6656 + lc, bcol0);
        else run<2, false>(acc, SGB, 2048, row0, colt - 8704 + lc, bcol0);
    }
};
template <int PASS> struct EpiMerge {
    static constexpr bool PERM = true, AFTER_DRAIN = false;
    bf16_t* O; const bf16_t* G;
    __device__ __forceinline__ void operator()(const f32x4 (&acc)[2][2][4][2], const Unit& u, int wr, int wc, int fr, int fq) const {
        const int row0 = u.pm * BM + wr * 64 + fr, col0 = u.pn * BM + wc * 32 + 8 * fq;
#pragma unroll
        for (int ai = 0; ai < 2; ++ai)
#pragma unroll
            for (int m = 0; m < 4; ++m) { const size_t off = (size_t)(row0 + ai * HALF + m * 16) * 2048 + col0;
#pragma unroll
                for (int bj = 0; bj < 2; ++bj) { const u32x2 gg = *(const u32x2*)((const unsigned char*)G + off + bj * HALF);
                    f32x4 v0 = acc[ai][bj][m][0] * (1.0f / 255.0f), v1 = acc[ai][bj][m][1] * (1.0f / 255.0f);
                    v0[0] *= (float)(gg.x & 255u); v0[1] *= (float)((gg.x >> 8) & 255u); v0[2] *= (float)((gg.x >> 16) & 255u); v0[3] *= (float)(gg.x >> 24);
                    v1[0] *= (float)(gg.y & 255u); v1[1] *= (float)((gg.y >> 8) & 255u); v1[2] *= (float)((gg.y >> 16) & 255u); v1[3] *= (float)(gg.y >> 24);
                    if (PASS == 2) { const u32x4 t = *(const u32x4*)(O + off + bj * HALF);
                        v0[0] += bflo(t.x); v0[1] += bfhi(t.x); v0[2] += bflo(t.y); v0[3] += bfhi(t.y); v1[0] += bflo(t.z); v1[1] += bfhi(t.z); v1[2] += bflo(t.w); v1[3] += bfhi(t.w); }
                    u32x4 w; w.x = cvt_pk_bf16(v0[0], v0[1]); w.y = cvt_pk_bf16(v0[2], v0[3]); w.z = cvt_pk_bf16(v1[0], v1[1]); w.w = cvt_pk_bf16(v1[2], v1[3]);
                    *(u32x4*)(O + off + bj * HALF) = w; }
                if (PASS == 1 ? (m == 3) : (m & 1)) asm volatile("" ::: "memory"); }
    }
};
template <int MODE> struct EpiResid {
    static constexpr bool PERM = true, AFTER_DRAIN = false;
    const float* xin32; const bf16_t* xin16; bf16_t* out; const float* gate; const float* bias;
    bf16_t* XG; const float* gcol; const float* sccol; float* ss;
    __device__ __forceinline__ void operator()(const f32x4 (&acc)[2][2][4][2], const Unit& u, int wr, int wc, int fr, int fq) const {
        const int row0 = u.pm * BM + wr * 64 + fr, col0 = u.pn * BM + wc * 32 + 8 * fq, bt = (u.pm * BM) >> 14;
        const float* gp = gate + (size_t)bt * 12288;
        f32x4 gv[2][2], bv[2][2], av[2][2];
#pragma unroll
        for (int bj = 0; bj < 2; ++bj)
#pragma unroll
            for (int n = 0; n < 2; ++n) { const int c = col0 + bj * HALF + 4 * n;
                gv[bj][n] = *(const f32x4*)(gp + c); bv[bj][n] = bias ? *(const f32x4*)(bias + c) : (f32x4){0.f, 0.f, 0.f, 0.f};
                if (MODE != 2) av[bj][n] = *(const f32x4*)(gcol + c) * (*(const f32x4*)(sccol + (size_t)bt * 12288 + c) + 1.0f); }
#pragma unroll
        for (int ai = 0; ai < 2; ++ai)
#pragma unroll
            for (int m = 0; m < 4; ++m) { const int row = row0 + ai * HALF + m * 16; const size_t off = (size_t)row * 2048 + col0; float sq = 0.f;
#pragma unroll
                for (int bj = 0; bj < 2; ++bj) { f32x4 x0, x1;
                    if (MODE == 0) { x0 = *(const f32x4*)(xin32 + off + bj * HALF); x1 = *(const f32x4*)(xin32 + off + bj * HALF + 4); }
                    else { const u32x4 xx = *(const u32x4*)(xin16 + off + bj * HALF); x0 = (f32x4){bflo(xx.x), bfhi(xx.x), bflo(xx.y), bfhi(xx.y)}; x1 = (f32x4){bflo(xx.z), bfhi(xx.z), bflo(xx.w), bfhi(xx.w)}; }
                    const f32x4 o0 = x0 + gv[bj][0] * (acc[ai][bj][m][0] + bv[bj][0]), o1 = x1 + gv[bj][1] * (acc[ai][bj][m][1] + bv[bj][1]);
                    { u32x4 w; w.x = cvt_pk_bf16(o0[0], o0[1]); w.y = cvt_pk_bf16(o0[2], o0[3]); w.z = cvt_pk_bf16(o1[0], o1[1]); w.w = cvt_pk_bf16(o1[2], o1[3]);
                      *(u32x4*)(out + off + bj * HALF) = w; }
                    const f32x4 q0 = o0 * o0, q1 = o1 * o1; sq += ((q0[0] + q0[1]) + (q0[2] + q0[3])) + ((q1[0] + q1[1]) + (q1[2] + q1[3]));
                    if (MODE != 2) { const f32x4 h0 = o0 * av[bj][0], h1 = o1 * av[bj][1];
                        u32x4 w; w.x = cvt_pk_bf16(h0[0], h0[1]); w.y = cvt_pk_bf16(h0[2], h0[3]); w.z = cvt_pk_bf16(h1[0], h1[1]); w.w = cvt_pk_bf16(h1[2], h1[3]);
                        *(u32x4*)(XG + off + bj * HALF) = w; } }
                sq += __shfl_xor(sq, 16); sq += __shfl_xor(sq, 32); if (fq == 0) atomicAdd(ss + row, sq);
                if (m & 1) asm volatile("" ::: "memory"); }
    }
};
struct EpiMlp1 {
    static constexpr bool PERM = true, AFTER_DRAIN = false;
    bf16_t* O; const float* cvec; const float* ss;
    __device__ __forceinline__ void operator()(const f32x4 (&acc)[2][2][4][2], const Unit& u, int wr, int wc, int fr, int fq) const {
        const int row0 = u.pm * BM + wr * 64 + fr, col0 = u.pn * BM + wc * 32 + 8 * fq;
        const float* cb = cvec + (size_t)((u.pm * BM) >> 14) * 8192;
        f32x4 bv[2][2];
#pragma unroll
        for (int bj = 0; bj < 2; ++bj)
#pragma unroll
            for (int n = 0; n < 2; ++n) bv[bj][n] = *(const f32x4*)(cb + col0 + bj * HALF + 4 * n);
#pragma unroll
        for (int ai = 0; ai < 2; ++ai)
#pragma unroll
            for (int m = 0; m < 4; ++m) { const int row = row0 + ai * HALF + m * 16; bf16_t* rowp = O + (size_t)row * 8192 + col0;
                const float rs = __builtin_amdgcn_rsqf(ss[row] * (1.0f / 2048.0f) + 1e-6f);
#pragma unroll
                for (int bj = 0; bj < 2; ++bj) { f32x4 v0 = acc[ai][bj][m][0] * rs + bv[bj][0], v1 = acc[ai][bj][m][1] * rs + bv[bj][1];
#pragma unroll
                    for (int j = 0; j < 4; ++j) { const float a = fmaxf(v0[j], 0.f), b = fmaxf(v1[j], 0.f); v0[j] = a * a; v1[j] = b * b; }
                    u32x4 w; w.x = cvt_pk_bf16(v0[0], v0[1]); w.y = cvt_pk_bf16(v0[2], v0[3]); w.z = cvt_pk_bf16(v1[0], v1[1]); w.w = cvt_pk_bf16(v1[2], v1[3]);
                    *(u32x4*)(rowp + bj * HALF) = w; } }
    }
};
template <class Epi, class Sched, bool ALIGN_EPI = false, bool SP2 = false>
__device__ __forceinline__ void gemm_phase(PG8_LAS unsigned char* lds, const Gemm g, const Sched& S, const Epi& E) {
    int tid_l = threadIdx.x; asm volatile("" : "+v"(tid_l));
    const int tid = tid_l, wid = __builtin_amdgcn_readfirstlane(tid >> 6), lane = tid & 63, wr = wid >> 2, wc = wid & 3, fr = lane & 15, fq = lane >> 4;
    const int K = g.K, nt = K / BK;
    unsigned voffA[2], voffB[2];
#pragma unroll
    for (int i = 0; i < 2; ++i) { int R, C; stage_rc(tid * 16 + i * 8192, R, C); const int Rb = Epi::PERM ? ((R & ~31) + perm32(R & 31)) : R;
        voffA[i] = (unsigned)(R * K + C) * 2u; voffB[i] = (unsigned)(Rb * K + C) * 2u; }
    const size_t kstep = (size_t)(BK * 2);
    const size_t hstep = (size_t)HALF * K * 2;
    const size_t tstep = 2 * hstep;
    const unsigned ldsw = (unsigned)wid * 1024u;
    const int aoff = lds_byte(wr * 64 + fr, fq * 8), boff = lds_byte(wc * 32 + fr, fq * 8);
#define PG8_SA(b, h) (((b) * 2 + (h)) * HTB)
#define PG8_SB(b, h) ((4 + (b) * 2 + (h)) * HTB)
#define PG8_STAGE(bufoff, gbase, voff) do { _Pragma("unroll") for (int _i = 0; _i < 2; ++_i) \
        __builtin_amdgcn_global_load_lds((const unsigned*)((const char*)(gbase) + (voff)[_i]), (PG8_LAS unsigned*)(lds + (bufoff) + ldsw + _i * 8192), 16, 0, 0); } while (0)
#define PG8_LDA(dst, b, h) do { _Pragma("unroll") for (int m = 0; m < 4; ++m) _Pragma("unroll") for (int k = 0; k < 2; ++k) dst[m][k] = *(const PG8_LAS bf16x8*)(lds + PG8_SA(b, h) + aoff + m * 2048 + k * 1024); } while (0)
#define PG8_LDB(dst, b, h) do { _Pragma("unroll") for (int n = 0; n < 2; ++n) _Pragma("unroll") for (int k = 0; k < 2; ++k) dst[n][k] = *(const PG8_LAS bf16x8*)(lds + PG8_SB(b, h) + boff + n * 2048 + k * 1024); } while (0)
#define PG8_MMA(ai, bj, At, Bt) do { __builtin_amdgcn_s_setprio(1); _Pragma("unroll") for (int m = 0; m < 4; ++m) _Pragma("unroll") for (int n = 0; n < 2; ++n) _Pragma("unroll") for (int k = 0; k < 2; ++k) \
        acc[ai][bj][m][n] = __builtin_amdgcn_mfma_f32_16x16x32_bf16(Bt[n][k], At[m][k], acc[ai][bj][m][n], 0, 0, 0); __builtin_amdgcn_s_setprio(0); } while (0)
#define PG8_WAIT_V(n) asm volatile("s_waitcnt vmcnt(" #n ")" ::: "memory")
#define PG8_WAIT_L(n) asm volatile("s_waitcnt lgkmcnt(" #n ")" ::: "memory")
#define PG8_BAR __builtin_amdgcn_s_barrier()
#define PG8_SCHED __builtin_amdgcn_sched_barrier(0)
    Unit cur, nxt; int ui = 0;
    if (!S.next(0, cur)) return;
    f32x4 acc[2][2][4][2];
#pragma unroll
    for (int a = 0; a < 2; ++a)
#pragma unroll
        for (int b = 0; b < 2; ++b)
#pragma unroll
            for (int m = 0; m < 4; ++m)
#pragma unroll
                for (int n = 0; n < 2; ++n) acc[a][b][m][n] = (f32x4){0.f, 0.f, 0.f, 0.f};
    bf16x8 At[4][2], B0[2][2], B1[2][2];
    const char* cA = (const char*)g.A + (size_t)cur.pm * tstep; const char* cB = (const char*)g.Bt + (size_t)cur.pn * tstep;
    S.a_ready(cur);
    if constexpr (SP2) {
        PG8_STAGE(PG8_SB(0, 0), cB, voffB); PG8_STAGE(PG8_SB(0, 1), cB + hstep, voffB); PG8_STAGE(PG8_SA(0, 0), cA, voffA); PG8_STAGE(PG8_SA(0, 1), cA + hstep, voffA);
        if (wr == 1) PG8_BAR;
        PG8_WAIT_V(2); PG8_BAR;
        PG8_STAGE(PG8_SB(1, 0), cB + kstep, voffB); PG8_STAGE(PG8_SA(1, 0), cA + kstep, voffA); PG8_STAGE(PG8_SB(1, 1), cB + hstep + kstep, voffB);
        PG8_WAIT_V(6); PG8_BAR;
    } else {
        PG8_STAGE(PG8_SB(0, 0), cB, voffB); PG8_STAGE(PG8_SA(0, 0), cA, voffA); PG8_STAGE(PG8_SB(0, 1), cB + hstep, voffB); PG8_STAGE(PG8_SA(0, 1), cA + hstep, voffA);
        if (wr == 1) PG8_BAR;
        PG8_WAIT_V(4); PG8_BAR;
        PG8_STAGE(PG8_SB(1, 0), cB + kstep, voffB); PG8_STAGE(PG8_SA(1, 0), cA + kstep, voffA); PG8_STAGE(PG8_SB(1, 1), cB + hstep + kstep, voffB);
        PG8_WAIT_V(6); PG8_BAR;
    }
    for (;;) {
        const bool has_next = S.next(ui + 1, nxt);
        const char* nA = has_next ? (const char*)g.A + (size_t)nxt.pm * tstep : cA; const char* nB = has_next ? (const char*)g.Bt + (size_t)nxt.pn * tstep : cB;
        for (int t = 0; t < nt; t += 2) {
            const bool last = (t == nt - 2);
            const char* a1 = cA + (size_t)(t + 1) * kstep;
            const char* a2 = last ? nA : cA + (size_t)(t + 2) * kstep; const char* b2 = last ? nB : cB + (size_t)(t + 2) * kstep;
            const char* a3 = a2 + kstep; const char* b3 = b2 + kstep;
            if (last && has_next) S.a_ready(nxt);
            if constexpr (SP2) {
            PG8_LDB(B0, 0, 0); PG8_LDB(B1, 0, 1); PG8_SCHED; PG8_LDA(At, 0, 0); PG8_STAGE(PG8_SA(1, 1), a1 + hstep, voffA);
            PG8_WAIT_V(8); PG8_WAIT_L(0); PG8_BAR; PG8_MMA(0, 0, At, B0); PG8_MMA(0, 1, At, B1); PG8_BAR; PG8_SCHED;
            PG8_LDA(At, 0, 1); PG8_STAGE(PG8_SB(0, 0), b2, voffB); PG8_STAGE(PG8_SB(0, 1), b2 + hstep, voffB); PG8_STAGE(PG8_SA(0, 0), a2, voffA);
            PG8_WAIT_V(8); PG8_WAIT_L(0); PG8_BAR; PG8_MMA(1, 0, At, B0); PG8_MMA(1, 1, At, B1); PG8_BAR; PG8_SCHED;
            PG8_LDB(B0, 1, 0); PG8_LDB(B1, 1, 1); PG8_SCHED; PG8_LDA(At, 1, 0); PG8_STAGE(PG8_SA(0, 1), a2 + hstep, voffA);
            PG8_WAIT_V(8); PG8_WAIT_L(0); PG8_BAR; PG8_MMA(0, 0, At, B0); PG8_MMA(0, 1, At, B1); PG8_BAR; PG8_SCHED;
            PG8_LDA(At, 1, 1); PG8_STAGE(PG8_SB(1, 0), b3, voffB); PG8_STAGE(PG8_SB(1, 1), b3 + hstep, voffB); PG8_STAGE(PG8_SA(1, 0), a3, voffA);
            PG8_WAIT_V(8); PG8_WAIT_L(0); PG8_BAR; PG8_MMA(1, 0, At, B0); PG8_MMA(1, 1, At, B1); PG8_BAR; PG8_SCHED;
            } else {
            PG8_LDB(B0, 0, 0); PG8_SCHED; PG8_LDA(At, 0, 0); PG8_STAGE(PG8_SA(1, 1), a1 + hstep, voffA);
            PG8_WAIT_L(8); PG8_BAR; PG8_WAIT_L(0); PG8_MMA(0, 0, At, B0); PG8_BAR; PG8_SCHED;
            PG8_LDB(B1, 0, 1); PG8_STAGE(PG8_SB(0, 0), b2, voffB);
            PG8_BAR; PG8_WAIT_L(0); PG8_MMA(0, 1, At, B1); PG8_BAR;
            PG8_LDA(At, 0, 1); PG8_STAGE(PG8_SA(0, 0), a2, voffA);
            PG8_BAR; PG8_WAIT_L(0); PG8_MMA(1, 0, At, B0); PG8_BAR; PG8_SCHED;
            PG8_STAGE(PG8_SB(0, 1), b2 + hstep, voffB);
            PG8_WAIT_V(6); PG8_BAR; PG8_MMA(1, 1, At, B1); PG8_BAR;
            PG8_LDB(B0, 1, 0); PG8_SCHED; PG8_LDA(At, 1, 0); PG8_STAGE(PG8_SA(0, 1), a2 + hstep, voffA);
            PG8_WAIT_L(8); PG8_BAR; PG8_WAIT_L(0); PG8_MMA(0, 0, At, B0); PG8_BAR; PG8_SCHED;
            PG8_LDB(B1, 1, 1); PG8_STAGE(PG8_SB(1, 0), b3, voffB);
            PG8_BAR; PG8_WAIT_L(0); PG8_MMA(0, 1, At, B1); PG8_BAR;
            PG8_LDA(At, 1, 1); PG8_STAGE(PG8_SA(1, 0), a3, voffA);
            PG8_BAR; PG8_WAIT_L(0); PG8_MMA(1, 0, At, B0); PG8_BAR; PG8_SCHED;
            PG8_STAGE(PG8_SB(1, 1), b3 + hstep, voffB);
            PG8_WAIT_V(6); PG8_BAR; PG8_MMA(1, 1, At, B1); PG8_BAR;
            }
        }
        if constexpr (ALIGN_EPI) { if (wr == 0) PG8_BAR; }
        if constexpr (!Epi::AFTER_DRAIN) { E(acc, cur, wr, wc, fr, fq); S.done(cur); }
        if (!has_next) break;
#pragma unroll
        for (int a = 0; a < 2; ++a)
#pragma unroll
            for (int b = 0; b < 2; ++b)
#pragma unroll
                for (int m = 0; m < 4; ++m)
#pragma unroll
                    for (int n = 0; n < 2; ++n) acc[a][b][m][n] = (f32x4){0.f, 0.f, 0.f, 0.f};
        cur = nxt; cA = nA; cB = nB; ++ui;
        if constexpr (ALIGN_EPI) { if (wr == 1) PG8_BAR; }
    }
    PG8_WAIT_V(0);
    if constexpr (!ALIGN_EPI) { if (wr == 0) PG8_BAR; }
    PG8_BAR;
    if constexpr (Epi::AFTER_DRAIN) { E.fused(acc, cur, wr, wc, fr, fq, lds, wid, lane); S.done(cur); }
#undef PG8_SA
#undef PG8_SB
#undef PG8_STAGE
#undef PG8_LDA
#undef PG8_LDB
#undef PG8_MMA
#undef PG8_WAIT_V
#undef PG8_WAIT_L
#undef PG8_BAR
#undef PG8_SCHED
}
}
using pg8::bflo; using pg8::bfhi;
#define cvt_pk_bf16_c pg8::cvt_pk_bf16
using pg8::bf16_t; using pg8::bf16x8; using pg8::f32x4; using pg8::u32x4;
#define LAS __attribute__((address_space(3)))
typedef short s16x4 __attribute__((ext_vector_type(4)));
typedef unsigned u32x2 __attribute__((ext_vector_type(2)));

constexpr int NB = 2, SEQ = 16384, T = NB * SEQ, D = 2048, DA = 1024, DB = 1536, DBO = 512, DFF = 8192, INC = 10752, NH = 12;
constexpr float EPS = 1e-6f;
constexpr size_t MiB = 1u << 20;
constexpr size_t WS_MOD = 1 * MiB;
constexpr size_t WS_LSE = 2 * MiB;
constexpr size_t WS_WSB = 4 * MiB;
constexpr size_t WS_VST = 4 * MiB + 512 * 1024;
constexpr size_t WS_W = 5 * MiB;
constexpr size_t WO_IN = 0, WO_OA = 42 * MiB, WO_OB = 46 * MiB, WO_OUT = 48 * MiB, WO_W1 = 56 * MiB, WO_W2 = 88 * MiB;
constexpr size_t WS_H = 125 * MiB;
constexpr size_t WS_BIG = 253 * MiB;
constexpr size_t BO_U = 0, BO_VA = 64 * MiB, BO_Q = 128 * MiB, BO_K = 224 * MiB, BO_V = 320 * MiB, BO_SGA = 416 * MiB, BO_SGB = 544 * MiB;
constexpr size_t WS_L1 = WS_BIG + 672 * MiB;
constexpr size_t WS_END = WS_L1 + 88 * MiB;
constexpr size_t WS_C1 = WS_MOD + 256 * 1024;
constexpr size_t WS_CIN = WS_MOD + 384 * 1024;
constexpr size_t WS_SS = WS_MOD + 512 * 1024;
struct WOff { size_t in, oa, ob, out, w1, w2; };
__device__ __forceinline__ WOff woff(int l) { WOff w;
    w.in = l == 0 ? WS_W + WO_IN : WS_L1; w.oa = l == 0 ? WS_W + WO_OA : WS_L1 + 74 * MiB; w.ob = l == 0 ? WS_W + WO_OB : WS_L1 + 78 * MiB;
    w.out = l == 0 ? WS_W + WO_OUT : WS_L1 + 80 * MiB; w.w1 = l == 0 ? WS_W + WO_W1 : WS_L1 + 42 * MiB; w.w2 = l == 0 ? WS_W + WO_W2 : WS_W + WO_IN; return w; }
constexpr int LDS_BYTES = 135168;
constexpr int NPHASE = 20;

struct Args { const float* in[20]; float* out; unsigned char* ws; };

__device__ __forceinline__ float wave_sum(float v) {
#pragma unroll
    for (int o = 1; o < 64; o <<= 1) v += __shfl_xor(v, o);
    return v;
}
__device__ __forceinline__ unsigned f2bf(float f) { unsigned u = __float_as_uint(f); return (u + 0x7fffu + ((u >> 16) & 1u)) >> 16; }
__device__ __forceinline__ unsigned pk2(float lo, float hi) { return f2bf(lo) | (f2bf(hi) << 16); }
__device__ __forceinline__ unsigned off_b(unsigned row, unsigned ch) { return 256u * row + 16u * (ch ^ (((row & 3u) << 2) | ((row >> 2) & 3u))); }

__device__ __forceinline__ void transpose_item(const float* W, int K, int N, bf16_t* WT, int item, int lane) {
    const int nblk = N / 256, kb = item / nblk, nb = item % nblk, k0 = 16 * kb, n0 = 256 * nb + 4 * lane;
    const float* src = W + (size_t)k0 * N + n0;
    f32x4 v[16];
#pragma unroll
    for (int i = 0; i < 16; ++i) v[i] = __builtin_nontemporal_load((const f32x4*)(src + (size_t)i * N));
#pragma unroll
    for (int c = 0; c < 4; ++c) { bf16_t* dst = WT + (size_t)(n0 + c) * K + k0;
        u32x4 lo, hi;
        lo.x = cvt_pk_bf16_c(v[0][c], v[1][c]); lo.y = cvt_pk_bf16_c(v[2][c], v[3][c]); lo.z = cvt_pk_bf16_c(v[4][c], v[5][c]); lo.w = cvt_pk_bf16_c(v[6][c], v[7][c]);
        hi.x = cvt_pk_bf16_c(v[8][c], v[9][c]); hi.y = cvt_pk_bf16_c(v[10][c], v[11][c]); hi.z = cvt_pk_bf16_c(v[12][c], v[13][c]); hi.w = cvt_pk_bf16_c(v[14][c], v[15][c]);
        *(u32x4*)dst = lo; *(u32x4*)(dst + 8) = hi; }
}
__device__ __forceinline__ void convert_layer_weights(const float* const* inp, unsigned char* ws, int l, LAS unsigned char* lds, int gw, int NGW, int wave, int lane) {
    const WOff wo = woff(l);
    const float* w_in = inp[5] + (size_t)l * D * INC;   const float* w_oa = inp[11] + (size_t)l * DA * D; const float* w_ob = inp[12] + (size_t)l * DBO * D;
    const float* w_out = inp[13] + (size_t)l * D * D;   const float* w1 = inp[15] + (size_t)l * D * DFF;  const float* w2 = inp[17] + (size_t)l * DFF * D;
    constexpr int I_IN = (D / 16) * (INC / 256), I_OA = (DA / 16) * (D / 256), I_OB = (DBO / 16) * (D / 256), I_OUT = (D / 16) * (D / 256), I_1 = (D / 16) * (DFF / 256), I_2 = (DFF / 16) * (D / 256);
    constexpr int NITEMS = I_IN + I_OA + I_OB + I_OUT + I_1 + I_2;
    for (int it = gw; it < NITEMS; it += NGW) {
        int r = it;
        if (r < I_IN) { transpose_item(w_in, D, INC, (bf16_t*)(ws + wo.in), r, lane); continue; } r -= I_IN;
        if (r < I_OA) { transpose_item(w_oa, DA, D, (bf16_t*)(ws + wo.oa), r, lane); continue; } r -= I_OA;
        if (r < I_OB) { transpose_item(w_ob, DBO, D, (bf16_t*)(ws + wo.ob), r, lane); continue; } r -= I_OB;
        if (r < I_OUT) { transpose_item(w_out, D, D, (bf16_t*)(ws + wo.out), r, lane); continue; } r -= I_OUT;
        if (r < I_1) { transpose_item(w1, D, DFF, (bf16_t*)(ws + wo.w1), r, lane); continue; } r -= I_1;
        transpose_item(w2, DFF, D, (bf16_t*)(ws + wo.w2), r, lane);
    }
}
template <bool SILU> __device__ __forceinline__ void gemv_item(const float* W, size_t ldw, const float* x0, const float* x1, const float* bias, float* out0, float* out1, int col0, LAS unsigned char* lds, int tid, int wave, int lane) {
    const int l5 = lane & 31, rg = wave * 2 + (lane >> 5), k0 = rg * 128;
    const float* Wp = W + (size_t)k0 * ldw + col0 + 4 * l5;
    f32x4 a0 = {0.f, 0.f, 0.f, 0.f}, a1 = {0.f, 0.f, 0.f, 0.f};
#pragma unroll 8
    for (int k = 0; k < 128; ++k) {
        const f32x4 w = __builtin_nontemporal_load((const f32x4*)(Wp + (size_t)k * ldw));
        float s0 = x0[k0 + k], s1 = x1[k0 + k];
        if (SILU) { s0 = s0 * __builtin_amdgcn_rcpf(1.0f + __expf(-s0)); s1 = s1 * __builtin_amdgcn_rcpf(1.0f + __expf(-s1)); }
        a0 += w * s0; a1 += w * s1;
    }
    LAS float* red = (LAS float*)lds;
    __syncthreads();
    *(LAS f32x4*)(red + (rg * 2 + 0) * 128 + l5 * 4) = a0;
    *(LAS f32x4*)(red + (rg * 2 + 1) * 128 + l5 * 4) = a1;
    __syncthreads();
    if (tid < 256) { const int b = tid >> 7, col = tid & 127; float sm = 0.f;
#pragma unroll
      for (int w = 0; w < 16; ++w) sm += red[(w * 2 + b) * 128 + col];
      (b ? out1 : out0)[col0 + col] = sm + bias[col0 + col]; }
    __syncthreads();
}
__device__ __forceinline__ void norm_phase(const float* x, const float* g, const float* shift, const float* scale, bf16_t* H, int gw, int NGW, int lane) {
    for (int b = 0; b < NB; ++b) {
        f32x4 ca[4][2], cs[4][2];
#pragma unroll
        for (int j = 0; j < 4; ++j)
#pragma unroll
            for (int h = 0; h < 2; ++h) { const int col = j * 512 + lane * 8 + h * 4;
                const f32x4 gg = *(const f32x4*)(g + col), sc = *(const f32x4*)(scale + b * 12288 + col);
                ca[j][h] = gg * (sc + 1.0f); cs[j][h] = *(const f32x4*)(shift + b * 12288 + col); }
        for (int r = gw; r < SEQ; r += NGW) {
            const float* xr = x + (size_t)(b * SEQ + r) * D;
            f32x4 v[4][2]; float ss = 0.f;
#pragma unroll
            for (int j = 0; j < 4; ++j)
#pragma unroll
                for (int h = 0; h < 2; ++h) { v[j][h] = *(const f32x4*)(xr + j * 512 + lane * 8 + h * 4); const f32x4 q = v[j][h] * v[j][h]; ss += (q[0] + q[1]) + (q[2] + q[3]); }
            const float rstd = 1.0f / sqrtf(wave_sum(ss) * (1.0f / D) + EPS);
            bf16_t* hr = H + (size_t)(b * SEQ + r) * D;
#pragma unroll
            for (int j = 0; j < 4; ++j) { const f32x4 o0 = v[j][0] * rstd * ca[j][0] + cs[j][0], o1 = v[j][1] * rstd * ca[j][1] + cs[j][1];
                u32x4 w; w.x = pk2(o0[0], o0[1]); w.y = pk2(o0[2], o0[3]); w.z = pk2(o1[0], o1[1]); w.w = pk2(o1[2], o1[3]);
                *(u32x4*)(hr + j * 512 + lane * 8) = w; }
        }
    }
}
__device__ __forceinline__ void final_norm_phase(const bf16_t* xb, const float* ssq, float* out, const float* g, int gw, int NGW, int lane) {
    f32x4 cg_[4][2];
#pragma unroll
    for (int j = 0; j < 4; ++j)
#pragma unroll
        for (int h = 0; h < 2; ++h) cg_[j][h] = *(const f32x4*)(g + j * 512 + lane * 8 + h * 4);
    for (int r = gw; r < T; r += NGW) {
        const bf16_t* xr = xb + (size_t)r * D; float* orow = out + (size_t)r * D;
        u32x4 v[4];
#pragma unroll
        for (int j = 0; j < 4; ++j) v[j] = *(const u32x4*)(xr + j * 512 + lane * 8);
        const float rstd = 1.0f / sqrtf(ssq[r] * (1.0f / D) + EPS);
#pragma unroll
        for (int j = 0; j < 4; ++j) { const f32x4 a = {bflo(v[j].x), bfhi(v[j].x), bflo(v[j].y), bfhi(v[j].y)}, b = {bflo(v[j].z), bfhi(v[j].z), bflo(v[j].w), bfhi(v[j].w)};
            *(f32x4*)(orow + j * 512 + lane * 8) = a * rstd * cg_[j][0]; *(f32x4*)(orow + j * 512 + lane * 8 + 4) = b * rstd * cg_[j][1]; }
    }
}
__device__ __forceinline__ s16x4 tr_read(LAS unsigned char* p) { return __builtin_amdgcn_ds_read_tr16_b64_v4i16((LAS s16x4*)p); }
__device__ __forceinline__ void attn_item(bf16_t* Q, const bf16_t* Kg, const bf16_t* Vg, float* lse, int item, int par, bool reuse, LAS unsigned char* lds, int tid, int wave, int lane) {
    const int n = item & 127, bh = item >> 7, h = bh % NH, b = bh / NH, grp = h >> 2;
    const int dsh = 2 * grp, d = 1 << dsh, nbsh = 7 - dsh;
    const int r = n >> nbsh, nblk = n & ((1 << nbsh) - 1);
    const int fr = lane & 15, fq = lane >> 4;
    LAS unsigned char* Kl = lds; LAS unsigned char* Vl = lds + 65536;
    __syncthreads();
    if (!reuse) {
        u32x4 kr[8], vr[8];
#pragma unroll
        for (int i = 0; i < 8; ++i) { const int id = tid + 512 * i, j = id >> 4, ch = id & 15; int mk = (nblk - 1) * 128 + j; mk = mk < 0 ? 0 : mk;
            const size_t go = ((size_t)(b * SEQ + (mk << dsh) + r)) * DB + h * 128 + ch * 8;
            kr[i] = *(const u32x4*)(Kg + go); vr[i] = *(const u32x4*)(Vg + go); }
#pragma unroll
        for (int i = 0; i < 8; ++i) { const int id = tid + 512 * i, j = id >> 4, ch = id & 15; const unsigned o = off_b((j + 128 * par) & 255, ch);
            *(LAS u32x4*)(Kl + o) = kr[i]; *(LAS u32x4*)(Vl + o) = vr[i]; }
    } else {
        u32x4 kr[4], vr[4];
#pragma unroll
        for (int i = 0; i < 4; ++i) { const int id = tid + 512 * i, j = 128 + (id >> 4), ch = id & 15; const int mk = (nblk - 1) * 128 + j;
            const size_t go = ((size_t)(b * SEQ + (mk << dsh) + r)) * DB + h * 128 + ch * 8;
            kr[i] = *(const u32x4*)(Kg + go); vr[i] = *(const u32x4*)(Vg + go); }
#pragma unroll
        for (int i = 0; i < 4; ++i) { const int id = tid + 512 * i, j = 128 + (id >> 4), ch = id & 15; const unsigned o = off_b((j + 128 * par) & 255, ch);
            *(LAS u32x4*)(Kl + o) = kr[i]; *(LAS u32x4*)(Vl + o) = vr[i]; }
    }
    const int qi = 16 * wave + fr;
    const size_t qrow = (size_t)(b * SEQ + (((nblk << 7) + qi) << dsh) + r);
    bf16x8 qf[4];
#pragma unroll
    for (int s = 0; s < 4; ++s) qf[s] = *(const bf16x8*)(Q + qrow * DB + h * 128 + 32 * s + 8 * fq);
    __syncthreads();
    const int T0 = 2 * (wave >> 1);
    const unsigned xk = ((fr & 3) << 2) | ((fr >> 2) & 3);
    f32x4 sacc[10];
#pragma unroll
    for (int kt = 0; kt < 10; ++kt) { sacc[kt] = (f32x4){0.f, 0.f, 0.f, 0.f};
#pragma unroll
        for (int s = 0; s < 4; ++s) { const bf16x8 kf = *(const LAS bf16x8*)(Kl + 4096u * ((T0 + kt + 8 * par) & 15) + 256u * fr + 16u * ((4 * s + fq) ^ xk));
            sacc[kt] = __builtin_amdgcn_mfma_f32_16x16x32_bf16(kf, qf[s], sacc[kt], 0, 0, 0); } }
    const float slope2 = exp2f(-8.0f * (float)(h + 1) / 12.0f) * (float)d * 1.4426950409f;
    const float sc2 = 0.08838834764831845f * 1.4426950409f;
    float mx = -3.0e38f;
    const int dist0 = 128 + qi - 16 * T0 - 4 * fq;
    const unsigned ub = (nblk > 0) ? 128u : (unsigned)qi;
#pragma unroll
    for (int kt = 0; kt < 10; ++kt)
#pragma unroll
        for (int e = 0; e < 4; ++e) { const int dist = dist0 - (16 * kt + e);
            const float s2 = sacc[kt][e] * sc2 - slope2 * (float)dist;
            sacc[kt][e] = ((unsigned)dist <= ub) ? s2 : -3.0e38f; mx = fmaxf(mx, sacc[kt][e]); }
    mx = fmaxf(mx, __shfl_xor(mx, 16)); mx = fmaxf(mx, __shfl_xor(mx, 32));
    float lsum = 0.f;
#pragma unroll
    for (int kt = 0; kt < 10; ++kt)
#pragma unroll
        for (int e = 0; e < 4; ++e) { const float p = __builtin_amdgcn_exp2f(sacc[kt][e] - mx); sacc[kt][e] = p; lsum += p; }
    lsum += __shfl_xor(lsum, 16); lsum += __shfl_xor(lsum, 32);
    bf16x8 pf[5];
#pragma unroll
    for (int ks = 0; ks < 5; ++ks) { u32x4 w; w.x = cvt_pk_bf16_c(sacc[2 * ks][0], sacc[2 * ks][1]); w.y = cvt_pk_bf16_c(sacc[2 * ks][2], sacc[2 * ks][3]);
        w.z = cvt_pk_bf16_c(sacc[2 * ks + 1][0], sacc[2 * ks + 1][1]); w.w = cvt_pk_bf16_c(sacc[2 * ks + 1][2], sacc[2 * ks + 1][3]); pf[ks] = __builtin_bit_cast(bf16x8, w); }
    const int q4 = fr >> 2, p4 = fr & 3;
    const unsigned xv = (q4 << 2) | fq;
    LAS unsigned char* vbase = Vl + 256u * (4 * fq + q4) + 8u * (p4 & 1);
    f32x4 oacc[8];
    const float inv = 1.0f / lsum;
    bf16_t* orow = Q + qrow * DB + h * 128 + 4 * fq;
#pragma unroll
    for (int c = 0; c < 8; ++c) { oacc[c] = (f32x4){0.f, 0.f, 0.f, 0.f};
        const unsigned co = 16u * ((2 * c + (p4 >> 1)) ^ xv);
#pragma unroll
        for (int ks = 0; ks < 5; ++ks) { const s16x4 lo = tr_read(vbase + co + 4096u * ((T0 + 2 * ks + 8 * par) & 15)), hi = tr_read(vbase + co + 4096u * ((T0 + 2 * ks + 1 + 8 * par) & 15));
            const bf16x8 vf = __builtin_shufflevector(lo, hi, 0, 1, 2, 3, 4, 5, 6, 7);
            oacc[c] = __builtin_amdgcn_mfma_f32_16x16x32_bf16(vf, pf[ks], oacc[c], 0, 0, 0); }
        u32x2 w; w.x = cvt_pk_bf16_c(oacc[c][0] * inv, oacc[c][1] * inv); w.y = cvt_pk_bf16_c(oacc[c][2] * inv, oacc[c][3] * inv);
        *(u32x2*)(orow + 16 * c) = w; }
    if (fq == 0) lse[qrow * NH + h] = (mx + __builtin_amdgcn_logf(lsum)) * 0.6931471805599453f;
}
__device__ __forceinline__ void gate_item(bf16_t* U, const bf16_t* VA, const bf16_t* WsB, const float* gv, const float* bv, const float* bs, const float* vst, int chunk, LAS unsigned char* lds, int tid, int wave, int lane) {
    const int fr = lane & 15, fq = lane >> 4;
    LAS unsigned char* Vi = lds; LAS unsigned char* Wi = lds + 32768; LAS float* st = (LAS float*)(lds + 65536);
    __syncthreads();
    if (tid < 128) { const float s1 = vst[2 * (size_t)(chunk * 128 + tid)], s2 = vst[2 * (size_t)(chunk * 128 + tid) + 1];
        const float mean = s1 * (1.0f / DA), var = fmaxf(s2 * (1.0f / DA) - mean * mean, 0.f);
        st[2 * tid] = mean; st[2 * tid + 1] = 1.0f / sqrtf(var + EPS); }
    const int ch = tid & 15, s0 = tid >> 4, q4 = fr >> 2, p4 = fr & 3;
    u32x4 pv[4], pw[4]; f32x4 g0, g1, b0, b1;
#define GATE_LOAD(g) do { _Pragma("unroll") for (int i = 0; i < 4; ++i) { pv[i] = *(const u32x4*)(VA + (size_t)(chunk * 128 + s0 + 32 * i) * DA + (g) * 128 + ch * 8); pw[i] = *(const u32x4*)(WsB + (size_t)((g) * 128 + s0 + 32 * i) * 128 + ch * 8); } \
        g0 = *(const f32x4*)(gv + (g) * 128 + ch * 8); g1 = *(const f32x4*)(gv + (g) * 128 + ch * 8 + 4); b0 = *(const f32x4*)(bv + (g) * 128 + ch * 8); b1 = *(const f32x4*)(bv + (g) * 128 + ch * 8 + 4); } while (0)
    GATE_LOAD(0);
#pragma unroll 1
    for (int g = 0; g < 8; ++g) {
        __syncthreads();
#pragma unroll
        for (int i = 0; i < 4; ++i) { const int s = s0 + 32 * i; const u32x4 a = pv[i];
            const float mean = st[2 * s], rstd = st[2 * s + 1];
            u32x4 w; w.x = cvt_pk_bf16_c((bflo(a.x) - mean) * rstd * g0[0] + b0[0], (bfhi(a.x) - mean) * rstd * g0[1] + b0[1]); w.y = cvt_pk_bf16_c((bflo(a.y) - mean) * rstd * g0[2] + b0[2], (bfhi(a.y) - mean) * rstd * g0[3] + b0[3]);
            w.z = cvt_pk_bf16_c((bflo(a.z) - mean) * rstd * g1[0] + b1[0], (bfhi(a.z) - mean) * rstd * g1[1] + b1[1]); w.w = cvt_pk_bf16_c((bflo(a.w) - mean) * rstd * g1[2] + b1[2], (bfhi(a.w) - mean) * rstd * g1[3] + b1[3]);
            *(LAS u32x4*)(Vi + off_b(s, ch)) = w;
            *(LAS u32x4*)(Wi + off_b(s, ch)) = pw[i]; }
        if (g < 7) GATE_LOAD(g + 1);
        const float bsv = bs[g * 128 + 16 * wave + fr];
        bf16_t* ur = U + (size_t)(chunk * 128 + 16 * wave + fr) * DA + g * 128 + 4 * fq;
        u32x2 uu[8];
#pragma unroll
        for (int c = 0; c < 8; ++c) uu[c] = *(const u32x2*)(ur + 16 * c);
        __syncthreads();
        f32x4 acc[8];
#pragma unroll
        for (int c = 0; c < 8; ++c) acc[c] = (f32x4){0.f, 0.f, 0.f, 0.f};
#pragma unroll 1
        for (int ks = 0; ks <= (wave >> 1); ++ks) {
            const bf16x8 wf = *(const LAS bf16x8*)(Wi + off_b(16 * wave + fr, 4 * ks + fq));
#pragma unroll
            for (int c = 0; c < 8; ++c) {
                const s16x4 lo = tr_read(Vi + off_b(32 * ks + 8 * fq + q4, 2 * c + (p4 >> 1)) + 8 * (p4 & 1)), hi = tr_read(Vi + off_b(32 * ks + 8 * fq + 4 + q4, 2 * c + (p4 >> 1)) + 8 * (p4 & 1));
                const bf16x8 vf = __builtin_shufflevector(lo, hi, 0, 1, 2, 3, 4, 5, 6, 7);
                acc[c] = __builtin_amdgcn_mfma_f32_16x16x32_bf16(vf, wf, acc[c], 0, 0, 0); } }
#pragma unroll
        for (int c = 0; c < 8; ++c) { const u32x2 u2 = uu[c];
            u32x2 w; w.x = cvt_pk_bf16_c(bflo(u2.x) * (acc[c][0] + bsv), bfhi(u2.x) * (acc[c][1] + bsv)); w.y = cvt_pk_bf16_c(bflo(u2.y) * (acc[c][2] + bsv), bfhi(u2.y) * (acc[c][3] + bsv));
            *(u32x2*)(ur + 16 * c) = w; }
    }
#undef GATE_LOAD
}
__device__ __forceinline__ void combine_phase(const bf16_t* O, const float* lse, bf16_t* YB, int gw, int NGW, int lane) {
    const int hg = lane >> 4, c8 = (lane & 15) * 8;
    for (int t = gw; t < T; t += NGW) {
        const float l0 = lse[(size_t)t * NH + hg], l1 = lse[(size_t)t * NH + 4 + hg], l2 = lse[(size_t)t * NH + 8 + hg];
        const float m = fmaxf(l0, fmaxf(l1, l2)); float w0 = __expf(l0 - m), w1 = __expf(l1 - m), w2 = __expf(l2 - m); const float inv = 1.0f / (w0 + w1 + w2); w0 *= inv; w1 *= inv; w2 *= inv;
        const bf16_t* op = O + (size_t)t * DB + hg * 128 + c8;
        const u32x4 a = *(const u32x4*)op, b = *(const u32x4*)(op + 512), c = *(const u32x4*)(op + 1024);
        u32x4 w;
        w.x = pk2(w0 * bflo(a.x) + w1 * bflo(b.x) + w2 * bflo(c.x), w0 * bfhi(a.x) + w1 * bfhi(b.x) + w2 * bfhi(c.x));
        w.y = pk2(w0 * bflo(a.y) + w1 * bflo(b.y) + w2 * bflo(c.y), w0 * bfhi(a.y) + w1 * bfhi(b.y) + w2 * bfhi(c.y));
        w.z = pk2(w0 * bflo(a.z) + w1 * bflo(b.z) + w2 * bflo(c.z), w0 * bfhi(a.z) + w1 * bfhi(b.z) + w2 * bfhi(c.z));
        w.w = pk2(w0 * bflo(a.w) + w1 * bflo(b.w) + w2 * bflo(c.w), w0 * bfhi(a.w) + w1 * bfhi(b.w) + w2 * bfhi(c.w));
        *(u32x4*)(YB + (size_t)t * DBO + hg * 128 + c8) = w;
    }
}

#define XB_TMO      128
#define XB_XCNT(j)  (256  + 64 * (j))
#define XB_XSUB(j)  (1280 + 64 * (j))
#define XB_XGEN(j)  (2304 + 64 * (j))
#define XB_TOP      3328
#define XB_TOPGEN   3392
#define XCD_BAR_WORDS 3456
#define XB_SPIN_CAP (1u << 18)

__device__ __forceinline__ unsigned xb_ld(unsigned* p)              { return __hip_atomic_load(p, __ATOMIC_RELAXED, __HIP_MEMORY_SCOPE_AGENT); }
__device__ __forceinline__ unsigned xb_add(unsigned* p, unsigned v) { return __hip_atomic_fetch_add(p, v, __ATOMIC_RELAXED, __HIP_MEMORY_SCOPE_AGENT); }
__device__ __forceinline__ unsigned xb_xcc_id() { return (unsigned)__builtin_amdgcn_s_getreg((3 << 11) | 20) & 0xFu; }
#define XB_SPIN(cond, bar) do { unsigned _sp = 0; while (cond) { __builtin_amdgcn_s_sleep(1); \
    if ((++_sp & 255u) == 0u) { if (xb_ld(&(bar)[XB_TMO])) break; if (_sp > XB_SPIN_CAP) { atomicAdd(&(bar)[XB_TMO], 1u); break; } } } } while (0)

struct XcdBarrier {
    unsigned* bar; unsigned x;
    volatile LAS unsigned* st;
};

__device__ __forceinline__ XcdBarrier xcd_barrier_post(unsigned* bar, volatile LAS unsigned* st) {
    XcdBarrier b; b.bar = bar; b.x = xb_xcc_id(); b.st = st;
    if (threadIdx.x == 0) (void)xb_add(&bar[XB_XCNT(b.x)], 1u);
    return b;
}
__device__ __forceinline__ void xcd_barrier_complete(unsigned* bar, unsigned x, unsigned& nloc, unsigned& nx) {
    const unsigned G = gridDim.x * gridDim.y * gridDim.z;
    unsigned sum, cnt, mine, sp = 0u;
    for (;;) {
        sum = 0u; cnt = 0u; mine = 0u;
#pragma unroll
        for (unsigned j = 0; j < 16; ++j) { const unsigned c = xb_ld(&bar[XB_XCNT(j)]); sum += c; cnt += (c > 0u) ? 1u : 0u; mine = (j == x) ? c : mine; }
        if (sum == G) break;
        __builtin_amdgcn_s_sleep(1);
        if ((++sp & 255u) == 0u) { if (xb_ld(&bar[XB_TMO])) break; if (sp > XB_SPIN_CAP) { atomicAdd(&bar[XB_TMO], 1u); break; } }
    }
    nloc = mine > 0u ? mine : 1u; nx = cnt > 0u ? cnt : 1u;
}

__device__ __forceinline__ void xcd_barrier(const XcdBarrier& b) {
    asm volatile("s_waitcnt vmcnt(0)" ::: "memory");
    __syncthreads();
    if (threadIdx.x == 0) {
        unsigned* bar = b.bar;
        __builtin_amdgcn_s_waitcnt(0);
        unsigned nloc = b.st[0], nx = b.st[1];
        if (nloc == 0u) { xcd_barrier_complete(bar, b.x, nloc, nx); b.st[0] = nloc; b.st[1] = nx; }
        const unsigned old = xb_add(&bar[XB_XSUB(b.x)], 1u);
        const unsigned gen = old / nloc;
        if (old + 1u == (gen + 1u) * nloc) {
            __builtin_amdgcn_fence(__ATOMIC_RELEASE, "agent");
            asm volatile("s_waitcnt vmcnt(0)" ::: "memory");
            const unsigned og = xb_add(&bar[XB_TOP], 1u);
            const unsigned tg = og / nx;
            if (og + 1u == (tg + 1u) * nx) xb_add(&bar[XB_TOPGEN], 1u);
            else XB_SPIN(xb_ld(&bar[XB_TOPGEN]) == tg, bar);
            __builtin_amdgcn_fence(__ATOMIC_ACQUIRE, "agent");
            xb_add(&bar[XB_XGEN(b.x)], 1u);
            asm volatile("s_waitcnt vmcnt(0)" ::: "memory");
        } else {
            XB_SPIN(xb_ld(&bar[XB_XGEN(b.x)]) == gen, bar);
            __builtin_amdgcn_fence(__ATOMIC_ACQUIRE, "agent");
            asm volatile("s_waitcnt vmcnt(0)" ::: "memory");
        }
    }
    __syncthreads();
}

#define CG_SYNC() do { asm volatile("s_waitcnt vmcnt(0)" ::: "memory");     \
    cg::this_grid().sync(); \
    __builtin_amdgcn_fence(__ATOMIC_ACQUIRE, "agent");                        \
    asm volatile("s_waitcnt vmcnt(0)" ::: "memory"); } while (0)
#define GRID_SYNC() do { XcdBarrier xb_; xb_.bar = (unsigned*)args.ws; xb_.x = xb_xcc_id(); xb_.st = (volatile LAS unsigned*)(lds + 131072 + 64); xcd_barrier(xb_); } while (0)
#define PHASE_VARS \
    int tid = threadIdx.x; asm volatile("" : "+v"(tid)); \
    const int lane = tid & 63, wave = __builtin_amdgcn_readfirstlane(tid >> 6), gw = bx * 8 + wave; (void)lane; (void)gw; \
    const float* const* inp = (const float* const*)__builtin_amdgcn_kernarg_segment_ptr(); asm volatile("" : "+s"(inp));     \
    unsigned char* ws = args.ws; asm volatile("" : "+s"(ws)); \
    float* xo = args.out; asm volatile("" : "+s"(xo)); (void)xo; bf16_t* XB = (bf16_t*)xo; (void)XB;     \
    float* mod = (float*)(ws + WS_MOD); float* lse = (float*)(ws + WS_LSE); bf16_t* WsB = (bf16_t*)(ws + WS_WSB); (void)mod; (void)lse; (void)WsB; \
    bf16_t* Wb = (bf16_t*)(ws + WS_W); bf16_t* H = (bf16_t*)(ws + WS_H); unsigned char* big = ws + WS_BIG; (void)Wb; (void)H; \
    bf16_t *U = (bf16_t*)(big + BO_U), *VA = (bf16_t*)(big + BO_VA), *Qb = (bf16_t*)(big + BO_Q), *Kb = (bf16_t*)(big + BO_K), *Vb = (bf16_t*)(big + BO_V), *SGA = (bf16_t*)(big + BO_SGA), *SGB = (bf16_t*)(big + BO_SGB); \
    (void)U; (void)VA; (void)Qb; (void)Kb; (void)Vb; (void)SGA; (void)SGB; \
    bf16_t* MRG = Kb; bf16_t* HID = (bf16_t*)big; bf16_t* YB = H; (void)MRG; (void)HID; (void)YB;
#define WPTR(off) ((const bf16_t*)((unsigned char*)Wb + (off)))

template <int L> __device__ __forceinline__ void layer_phases(const Args& args, LAS unsigned char* lds, const int G, const int bx, const int NGW) {
    constexpr int l = L;
    if (l == 0) {
        { PHASE_VARS
          for (int it = bx; it < 212; it += G) {
              if (it < 128) { const int ll = it >> 6, cb = it & 63; const float* sh = mod + (size_t)ll * 2 * 12288 + 3 * D; float* c1 = (float*)(ws + WS_C1) + (size_t)ll * 2 * 8192;
                  gemv_item<false>(inp[15] + (size_t)ll * D * DFF, DFF, sh, sh + 12288, inp[16] + (size_t)ll * DFF, c1, c1 + 8192, cb * 128, lds, tid, wave, lane); }
              else { const int cb = it - 128; const float* sh = mod + (size_t)2 * 12288; float* cin = (float*)(ws + WS_CIN);
                  gemv_item<false>(inp[5] + (size_t)D * INC, INC, sh, sh + 12288, inp[6] + INC, cin, cin + INC, cb * 128, lds, tid, wave, lane); } }
          norm_phase(inp[0], inp[4], mod + 0 * D, mod + 1 * D, H, gw, NGW, lane); }
        GRID_SYNC();
    }
    for (int rep = 0; rep < 1 + ((REP_MASK >> 2) & 1); ++rep) {
    { PHASE_VARS const WOff wo = woff(l); pg8::Gemm g{H, (const bf16_t*)(ws + wo.in), T, INC, D}; pg8::StaticOrder S; S.init(T, INC, G, bx);
      pg8::EpiInProj E{U, VA, Qb, Kb, Vb, SGA, SGB, l == 0 ? inp[6] : (const float*)(ws + WS_CIN), l == 0 ? 0 : INC, l == 0 ? nullptr : (const float*)(ws + WS_SS) + T, (float*)(ws + WS_VST) + (size_t)l * 2 * T};
      pg8::gemm_phase<pg8::EpiInProj, pg8::StaticOrder, true, true>(lds, g, S, E); }
    GRID_SYNC(); }
    { PHASE_VARS
      { const int per = (NB * NH * 128 + G - 1) / G; int par = 0, prev_bh = -1;
        for (int k = 0; k < per; ++k) { const int it = bx * per + k; if (it >= NB * NH * 128) break;
            const int bh = it >> 7; const bool reuse = (k > 0) && (bh == prev_bh); par = reuse ? (par ^ 1) : 0; prev_bh = bh;
            attn_item(Qb, Kb, Vb, lse, it, par, reuse, lds, tid, wave, lane); } }
      for (int it = bx; it < T / 128; it += G) gate_item(U, VA, WsB + (size_t)l * 8 * 128 * 128, inp[7] + l * DA, inp[8] + l * DA, inp[10] + l * 8 * 128, (const float*)(ws + WS_VST) + (size_t)l * 2 * T, it, lds, tid, wave, lane); }
    GRID_SYNC();
    { PHASE_VARS combine_phase(Qb, lse, YB, gw, NGW, lane);
      if (l == 0) convert_layer_weights(inp, ws, 1, lds, gw, NGW, wave, lane); }
    GRID_SYNC();
    for (int rep = 0; rep < 1 + ((REP_MASK >> 5) & 1); ++rep) {
    { PHASE_VARS const WOff wo = woff(l); pg8::Gemm g{U, (const bf16_t*)(ws + wo.oa), T, D, DA}; pg8::StaticOrder S; S.init(T, D, G, bx);
      pg8::EpiMerge<1> E{MRG, SGA};
      pg8::gemm_phase<pg8::EpiMerge<1>, pg8::StaticOrder, true, true>(lds, g, S, E); }
    { PHASE_VARS const WOff wo = woff(l); pg8::Gemm g{YB, (const bf16_t*)(ws + wo.ob), T, D, DBO}; pg8::StaticOrder S; S.init(T, D, G, bx);
      pg8::EpiMerge<2> E{MRG, SGB};
      pg8::gemm_phase<pg8::EpiMerge<2>, pg8::StaticOrder, true, true>(lds, g, S, E); }
    GRID_SYNC(); }
    {
    { PHASE_VARS const WOff wo = woff(l); const float* modl = mod + (size_t)l * 2 * 12288; const float* xin = (l == 0) ? inp[0] : xo;
      pg8::Gemm g{MRG, (const bf16_t*)(ws + wo.out), T, D, D}; pg8::StaticOrder S; S.init(T, D, G, bx);
      if (l == 0) { pg8::EpiResid<0> E{inp[0], nullptr, XB, modl + 2 * D, nullptr, H, inp[14] + l * D, modl + 4 * D, (float*)(ws + WS_SS) + (size_t)(2 * l) * T};
          pg8::gemm_phase<pg8::EpiResid<0>, pg8::StaticOrder, true, true>(lds, g, S, E); }
      else { pg8::EpiResid<1> E{nullptr, XB, XB, modl + 2 * D, nullptr, H, inp[14] + l * D, modl + 4 * D, (float*)(ws + WS_SS) + (size_t)(2 * l) * T};
          pg8::gemm_phase<pg8::EpiResid<1>, pg8::StaticOrder, true, true>(lds, g, S, E); } }
    GRID_SYNC(); }
    for (int rep = 0; rep < 1 + ((REP_MASK >> 8) & 1); ++rep) {
    { PHASE_VARS const WOff wo = woff(l); pg8::Gemm g{H, (const bf16_t*)(ws + wo.w1), T, DFF, D}; pg8::StaticOrder S; S.init(T, DFF, G, bx);
      pg8::EpiMlp1 E{HID, (const float*)(ws + WS_C1) + (size_t)l * 2 * 8192, (const float*)(ws + WS_SS) + (size_t)(2 * l) * T};
      pg8::gemm_phase<pg8::EpiMlp1, pg8::StaticOrder, true, true>(lds, g, S, E); }
    GRID_SYNC(); }
    {
    { PHASE_VARS const WOff wo = woff(l); const float* modl = mod + (size_t)l * 2 * 12288;
      pg8::Gemm g{HID, (const bf16_t*)(ws + wo.w2), T, D, DFF}; pg8::StaticOrder S; S.init(T, D, G, bx);
      if (l == 0) { pg8::EpiResid<1> E{nullptr, XB, XB, modl + 5 * D, inp[18] + (size_t)l * D, H, inp[4] + D, mod + (size_t)2 * 12288 + 1 * D, (float*)(ws + WS_SS) + T};
          pg8::gemm_phase<pg8::EpiResid<1>, pg8::StaticOrder, true, true>(lds, g, S, E); }
      else { pg8::EpiResid<2> E{nullptr, XB, H, modl + 5 * D, inp[18] + (size_t)l * D, nullptr, nullptr, nullptr, (float*)(ws + WS_SS) + (size_t)3 * T};
          pg8::gemm_phase<pg8::EpiResid<2>, pg8::StaticOrder, true, true>(lds, g, S, E); } }
    GRID_SYNC(); }
}

__global__ void __launch_bounds__(512, 2) fwd_kernel(Args args) {
    extern __shared__ __attribute__((aligned(16))) unsigned char lds_raw[];
    LAS unsigned char* lds = (LAS unsigned char*)lds_raw;
    const int G = gridDim.x, bx = blockIdx.x, NGW = G * 8;
    if (threadIdx.x < 64) ((volatile LAS unsigned*)(lds + 131072))[threadIdx.x] = 0u;
    __syncthreads();
    (void)xcd_barrier_post((unsigned*)args.ws, (volatile LAS unsigned*)(lds + 131072 + 64));
    { PHASE_VARS
      for (int i = bx * 512 + tid; i < 2 * 8 * 128 * 128; i += G * 512) { const int s = i & 127, t = (i >> 7) & 127; WsB[i] = (bf16_t)f2bf(s <= t ? inp[9][i] : 0.f); }
      for (int i = bx * 512 + tid; i < 4 * T; i += G * 512) ((float*)(ws + WS_SS))[i] = 0.f;
      for (int i = bx * 512 + tid; i < 4 * T; i += G * 512) ((float*)(ws + WS_VST))[i] = 0.f;
      for (int it = bx; it < 192; it += G) { const int ll = it / 96, cb = it % 96;
        gemv_item<true>(inp[2] + (size_t)ll * D * 12288, 12288, inp[1], inp[1] + D, inp[3] + (size_t)ll * 12288, mod + (size_t)(ll * 2) * 12288, mod + (size_t)(ll * 2 + 1) * 12288, cb * 128, lds, tid, wave, lane); }
      convert_layer_weights(inp, ws, 0, lds, gw, NGW, wave, lane); }
    if (G > 65536) CG_SYNC();
    GRID_SYNC();
    for (int i = 0; i < EXTRA_SYNCS; ++i) GRID_SYNC();
    layer_phases<0>(args, lds, G, bx, NGW);
    layer_phases<1>(args, lds, G, bx, NGW);
    { PHASE_VARS final_norm_phase(H, (const float*)(ws + WS_SS) + (size_t)3 * T, xo, inp[19], gw, NGW, lane); }
}

extern "C" void kernel_launch(void* const* d_in, const int* in_sizes, int n_in, void* d_out, int out_size, void* d_ws, size_t ws_size, hipStream_t stream) {
    static int grid = 0;
    if (grid == 0) {
        if (n_in != 20 || ws_size < WS_END || out_size != T * D) { fprintf(stderr, "kernel_launch: unexpected problem (n_in %d, ws %zu, out %d)\n", n_in, ws_size, out_size); grid = -1; return; }
        int dev = 0, cus = 0, per_cu = 0;
        hipGetDevice(&dev); hipDeviceGetAttribute(&cus, hipDeviceAttributeMultiprocessorCount, dev);
        if (hipFuncSetAttribute((const void*)fwd_kernel, hipFuncAttributeMaxDynamicSharedMemorySize, LDS_BYTES) != hipSuccess) { fprintf(stderr, "hipFuncSetAttribute failed\n"); grid = -1; return; }
        hipOccupancyMaxActiveBlocksPerMultiprocessor(&per_cu, (const void*)fwd_kernel, 512, LDS_BYTES);
        if (per_cu < 1) { fprintf(stderr, "occupancy query says %d\n", per_cu); per_cu = 1; }
        (void)hipGetLastError();
        grid = cus * 1;
    }
    if (grid < 0) return;
    if (hipMemsetAsync(d_ws, 0, 16384, stream) != hipSuccess) { fprintf(stderr, "memset failed\n"); return; }
    Args a{};
    for (int i = 0; i < 20; ++i) a.in[i] = (const float*)d_in[i];
    a.out = (float*)d_out; a.ws = (unsigned char*)d_ws;
    void* kargs[] = {&a};
    hipError_t e = hipLaunchCooperativeKernel((const void*)fwd_kernel, dim3(grid), dim3(512), kargs, LDS_BYTES, stream);
    if (e != hipSuccess) fprintf(stderr, "cooperative launch failed: %s (grid %d)\n", hipGetErrorString(e), grid);
}
```

```cpp
#include <hip/hip_runtime.h>
#include <hip/hip_cooperative_groups.h>
#include <cstdio>
#include <cstdint>
namespace cg = cooperative_groups;
#ifndef PHMASK
#define PHMASK 0xFFFFF
#endif
#define PHON(k) ((PHMASK >> (k)) & 1)
#ifndef DBG
#define DBG 0
#endif
#ifndef REP_MASK
#define REP_MASK 0
#endif
#ifndef PAIR_REP
#define PAIR_REP 0
#endif
#ifndef REP_DUMMY
#define REP_DUMMY 0
#endif
#ifndef EXTRA_SYNCS
#define EXTRA_SYNCS 0
#endif
#ifndef ONE_LAUNCH
#define ONE_LAUNCH 1
#endif
namespace pg8 {
#define PG8_LAS __attribute__((address_space(3)))
typedef unsigned short bf16_t;
typedef short bf16x8 __attribute__((ext_vector_type(8)));
typedef float f32x4 __attribute__((ext_vector_type(4)));
typedef unsigned u32x4 __attribute__((ext_vector_type(4)));
typedef unsigned u32x2 __attribute__((ext_vector_type(2)));
constexpr int BM = 256, BK = 64, HALF = 128, HTB = HALF * BK * 2  , STAGE_BYTES = 8 * HTB, NXCD = 8, WGM = 4;

__host__ __device__ __forceinline__ int lds_byte(int r, int c) { const int st = (r >> 4) * 2 + (c >> 5), rr = r & 15, cc = c & 31, ob = rr * 64 + cc * 2; return st * 1024 + (ob ^ (((ob >> 9) & 1) << 5)); }
__host__ __device__ __forceinline__ void stage_rc(int b, int& R, int& C) { const int st = b / 1024, sb = b % 1024, swz = sb ^ (((sb >> 9) & 1) << 5); R = (st >> 1) * 16 + swz / 64; C = (st & 1) * 32 + (swz % 64) / 2; }
__host__ __device__ __forceinline__ int perm32(int rho) { const int n = rho >> 4, i = rho & 15; return 8 * (i >> 2) + 4 * n + (i & 3); }

struct Unit { int pm, pn; };
struct Gemm { const bf16_t* A; const bf16_t* Bt; int M, N, K; };

struct StaticOrder {
    int nM, nN, nwg, G, c;
    __host__ __device__ void init(int M, int N, int G_, int c_) { nM = M / BM; nN = N / BM; nwg = nM * nN; G = G_; c = c_; }
    __host__ __device__ bool next(int i, Unit& u) const {
        const long L = (long)i * G + c; if (L >= nwg) return false;
        int wgid = (int)L; { const int q = nwg / NXCD, r = nwg % NXCD, xcd = wgid % NXCD, off = wgid / NXCD; wgid = (xcd < r ? xcd * (q + 1) : r * (q + 1) + (xcd - r) * q) + off; }
        const int nig = WGM * nN, gid = wgid / nig, fm = gid * WGM, gsz = (nM - fm) < WGM ? (nM - fm) : WGM;
        u.pm = fm + ((wgid % nig) % gsz); u.pn = (wgid % nig) / gsz; return true;
    }
    __device__ __forceinline__ void a_ready(const Unit&) const {}
    __device__ __forceinline__ void done(const Unit&) const {}
};
typedef __bf16 bf2_t __attribute__((ext_vector_type(2)));
typedef float f2_t __attribute__((ext_vector_type(2)));
__device__ __forceinline__ unsigned cvt_pk_bf16(float lo, float hi) { return __builtin_bit_cast(unsigned, __builtin_convertvector((f2_t){lo, hi}, bf2_t)); }
__device__ __forceinline__ float bflo(unsigned u) { return __uint_as_float(u << 16); }
__device__ __forceinline__ float bfhi(unsigned u) { return __uint_as_float(u & 0xffff0000u); }
__device__ __forceinline__ float act_gelu(float x) {
    const float e = __builtin_amdgcn_exp2f(x * (-2.302208198f - 0.1029432315f * x * x));
    return x * __builtin_amdgcn_rcpf(1.0f + e);
}
__device__ __forceinline__ float act_sigmoid(float x) { return __builtin_amdgcn_rcpf(1.0f + __builtin_amdgcn_exp2f(-1.4426950409f * x)); }

struct EpiInProj {
    static constexpr bool PERM = true, AFTER_DRAIN = false;
    bf16_t *U, *VA, *Q, *KK, *VV, *SGA, *SGB; const float* bias; int bstride; const float* ss;
    float* vst;
    template <int ACT, bool STATS> __device__ __forceinline__ void run(const f32x4 (&acc)[2][2][4][2], bf16_t* base, int ldc, int row0, int col0, int bcol0) const {
        f32x4 bv[2][2]; const float* bias = this->bias + (size_t)(row0 >> 14) * bstride;
#pragma unroll
        for (int bj = 0; bj < 2; ++bj)
#pragma unroll
            for (int n = 0; n < 2; ++n) bv[bj][n] = *(const f32x4*)(bias + bcol0 + bj * HALF + 4 * n);
#pragma unroll
        for (int ai = 0; ai < 2; ++ai)
#pragma unroll
            for (int m = 0; m < 4; ++m) { const int row = row0 + ai * HALF + m * 16; bf16_t* rowp = base + (size_t)row * ldc + col0;
                const float rs = ss ? __builtin_amdgcn_rsqf(ss[row] * (1.0f / 2048.0f) + 1e-6f) : 1.0f; float s1 = 0.f, s2 = 0.f;
#pragma unroll
                for (int bj = 0; bj < 2; ++bj) { f32x4 v0 = acc[ai][bj][m][0] * rs + bv[bj][0], v1 = acc[ai][bj][m][1] * rs + bv[bj][1];
                    if (ACT == 1) {
#pragma unroll
                        for (int j = 0; j < 4; ++j) { v0[j] = act_gelu(v0[j]); v1[j] = act_gelu(v1[j]); } }
                    if (ACT == 2) {
#pragma unroll
                        for (int j = 0; j < 4; ++j) { v0[j] = act_sigmoid(v0[j]); v1[j] = act_sigmoid(v1[j]); } }
                    if (STATS) { s1 += ((v0[0] + v0[1]) + (v0[2] + v0[3])) + ((v1[0] + v1[1]) + (v1[2] + v1[3])); const f32x4 q0 = v0 * v0, q1 = v1 * v1; s2 += ((q0[0] + q0[1]) + (q0[2] + q0[3])) + ((q1[0] + q1[1]) + (q1[2] + q1[3])); }
                    if (ACT == 2) {
                        const unsigned lo = (unsigned)__builtin_rintf(v0[0] * 255.f) | ((unsigned)__builtin_rintf(v0[1] * 255.f) << 8) | ((unsigned)__builtin_rintf(v0[2] * 255.f) << 16) | ((unsigned)__builtin_rintf(v0[3] * 255.f) << 24);
                        const unsigned hi = (unsigned)__builtin_rintf(v1[0] * 255.f) | ((unsigned)__builtin_rintf(v1[1] * 255.f) << 8) | ((unsigned)__builtin_rintf(v1[2] * 255.f) << 16) | ((unsigned)__builtin_rintf(v1[3] * 255.f) << 24);
                        u32x2 w8; w8.x = lo; w8.y = hi; *(u32x2*)((unsigned char*)base + (size_t)row * ldc + col0 + bj * HALF) = w8; continue; }
                    u32x4 w; w.x = cvt_pk_bf16(v0[0], v0[1]); w.y = cvt_pk_bf16(v0[2], v0[3]); w.z = cvt_pk_bf16(v1[0], v1[1]); w.w = cvt_pk_bf16(v1[2], v1[3]);
                    *(u32x4*)(rowp + bj * HALF) = w; }
                if (STATS) { s1 += __shfl_xor(s1, 16); s1 += __shfl_xor(s1, 32); s2 += __shfl_xor(s2, 16); s2 += __shfl_xor(s2, 32); if ((threadIdx.x & 48) == 0) { atomicAdd(vst + 2 * (size_t)row, s1); atomicAdd(vst + 2 * (size_t)row + 1, s2); } } }
    }
    __device__ __forceinline__ void operator()(const f32x4 (&acc)[2][2][4][2], const Unit& u, int wr, int wc, int fr, int fq) const {
        const int row0 = u.pm * BM + wr * 64 + fr, colt = u.pn * BM, lc = wc * 32 + 8 * fq, bcol0 = colt + lc;
        if (colt < 1024) run<1, false>(acc, U, 1024, row0, colt + lc, bcol0);
        else if (colt < 2048) run<1, true>(acc, VA, 1024, row0, colt - 1024 + lc, bcol0);
        else if (colt < 3584) run<0, false>(acc, Q, 1536, row0, colt - 2048 + lc, bcol0);
        else if (colt < 5120) run<0, false>(acc, KK, 1536, row0, colt - 3584 + lc, bcol0);
        else if (colt < 6656) run<0, false>(acc, VV, 1536, row0, colt - 5120 + lc, bcol0);
        else if (colt < 8704) run<2, false>(acc, SGA, 2048, row0, colt - 6656 + lc, bcol0);
        else run<2, false>(acc, SGB, 2048, row0, colt - 8704 + lc, bcol0);
    }
};
template <int PASS> struct EpiMerge {
    static constexpr bool PERM = true, AFTER_DRAIN = false;
    bf16_t* O; const bf16_t* G;
    __device__ __forceinline__ void operator()(const f32x4 (&acc)[2][2][4][2], const Unit& u, int wr, int wc, int fr, int fq) const {
        const int row0 = u.pm * BM + wr * 64 + fr, col0 = u.pn * BM + wc * 32 + 8 * fq;
#pragma unroll
        for (int ai = 0; ai < 2; ++ai)
#pragma unroll
            for (int m = 0; m < 4; ++m) { const size_t off = (size_t)(row0 + ai * HALF + m * 16) * 2048 + col0;
#pragma unroll
                for (int bj = 0; bj < 2; ++bj) { const u32x2 gg = *(const u32x2*)((const unsigned char*)G + off + bj * HALF);
                    f32x4 v0 = acc[ai][bj][m][0] * (1.0f / 255.0f), v1 = acc[ai][bj][m][1] * (1.0f / 255.0f);
                    v0[0] *= (float)(gg.x & 255u); v0[1] *= (float)((gg.x >> 8) & 255u); v0[2] *= (float)((gg.x >> 16) & 255u); v0[3] *= (float)(gg.x >> 24);
                    v1[0] *= (float)(gg.y & 255u); v1[1] *= (float)((gg.y >> 8) & 255u); v1[2] *= (float)((gg.y >> 16) & 255u); v1[3] *= (float)(gg.y >> 24);
                    if (PASS == 2) { const u32x4 t = *(const u32x4*)(O + off + bj * HALF);
                        v0[0] += bflo(t.x); v0[1] += bfhi(t.x); v0[2] += bflo(t.y); v0[3] += bfhi(t.y); v1[0] += bflo(t.z); v1[1] += bfhi(t.z); v1[2] += bflo(t.w); v1[3] += bfhi(t.w); }
                    u32x4 w; w.x = cvt_pk_bf16(v0[0], v0[1]); w.y = cvt_pk_bf16(v0[2], v0[3]); w.z = cvt_pk_bf16(v1[0], v1[1]); w.w = cvt_pk_bf16(v1[2], v1[3]);
                    *(u32x4*)(O + off + bj * HALF) = w; }
                if (PASS == 1 ? (m == 3) : (m & 1)) asm volatile("" ::: "memory"); }
    }
};
template <int MODE> struct EpiResid {
    static constexpr bool PERM = true, AFTER_DRAIN = false;
    const float* xin32; const bf16_t* xin16; bf16_t* out; const float* gate; const float* bias;
    bf16_t* XG; const float* gcol; const float* sccol; float* ss;
    __device__ __forceinline__ void operator()(const f32x4 (&acc)[2][2][4][2], const Unit& u, int wr, int wc, int fr, int fq) const {
        const int row0 = u.pm * BM + wr * 64 + fr, col0 = u.pn * BM + wc * 32 + 8 * fq, bt = (u.pm * BM) >> 14;
        const float* gp = gate + (size_t)bt * 12288;
        f32x4 gv[2][2], bv[2][2], av[2][2];
#pragma unroll
        for (int bj = 0; bj < 2; ++bj)
#pragma unroll
            for (int n = 0; n < 2; ++n) { const int c = col0 + bj * HALF + 4 * n;
                gv[bj][n] = *(const f32x4*)(gp + c); bv[bj][n] = bias ? *(const f32x4*)(bias + c) : (f32x4){0.f, 0.f, 0.f, 0.f};
                if (MODE != 2) av[bj][n] = *(const f32x4*)(gcol + c) * (*(const f32x4*)(sccol + (size_t)bt * 12288 + c) + 1.0f); }
#pragma unroll
        for (int ai = 0; ai < 2; ++ai)
#pragma unroll
            for (int m = 0; m < 4; ++m) { const int row = row0 + ai * HALF + m * 16; const size_t off = (size_t)row * 2048 + col0; float sq = 0.f;
#pragma unroll
                for (int bj = 0; bj < 2; ++bj) { f32x4 x0, x1;
                    if (MODE == 0) { x0 = *(const f32x4*)(xin32 + off + bj * HALF); x1 = *(const f32x4*)(xin32 + off + bj * HALF + 4); }
                    else { const u32x4 xx = *(const u32x4*)(xin16 + off + bj * HALF); x0 = (f32x4){bflo(xx.x), bfhi(xx.x), bflo(xx.y), bfhi(xx.y)}; x1 = (f32x4){bflo(xx.z), bfhi(xx.z), bflo(xx.w), bfhi(xx.w)}; }
                    const f32x4 o0 = x0 + gv[bj][0] * (acc[ai][bj][m][0] + bv[bj][0]), o1 = x1 + gv[bj][1] * (acc[ai][bj][m][1] + bv[bj][1]);
                    { u32x4 w; w.x = cvt_pk_bf16(o0[0], o0[1]); w.y = cvt_pk_bf16(o0[2], o0[3]); w.z = cvt_pk_bf16(o1[0], o1[1]); w.w = cvt_pk_bf16(o1[2], o1[3]);
                      *(u32x4*)(out + off + bj * HALF) = w; }
                    const f32x4 q0 = o0 * o0, q1 = o1 * o1; sq += ((q0[0] + q0[1]) + (q0[2] + q0[3])) + ((q1[0] + q1[1]) + (q1[2] + q1[3]));
                    if (MODE != 2) { const f32x4 h0 = o0 * av[bj][0], h1 = o1 * av[bj][1];
                        u32x4 w; w.x = cvt_pk_bf16(h0[0], h0[1]); w.y = cvt_pk_bf16(h0[2], h0[3]); w.z = cvt_pk_bf16(h1[0], h1[1]); w.w = cvt_pk_bf16(h1[2], h1[3]);
                        *(u32x4*)(XG + off + bj * HALF) = w; } }
                sq += __shfl_xor(sq, 16); sq += __shfl_xor(sq, 32); if (fq == 0) atomicAdd(ss + row, sq);
                if (m & 1) asm volatile("" ::: "memory"); }
    }
};
struct EpiMlp1 {
    static constexpr bool PERM = true, AFTER_DRAIN = false;
    bf16_t* O; const float* cvec; const float* ss;
    __device__ __forceinline__ void operator()(const f32x4 (&acc)[2][2][4][2], const Unit& u, int wr, int wc, int fr, int fq) const {
        const int row0 = u.pm * BM + wr * 64 + fr, col0 = u.pn * BM + wc * 32 + 8 * fq;
        const float* cb = cvec + (size_t)((u.pm * BM) >> 14) * 8192;
        f32x4 bv[2][2];
#pragma unroll
        for (int bj = 0; bj < 2; ++bj)
#pragma unroll
            for (int n = 0; n < 2; ++n) bv[bj][n] = *(const f32x4*)(cb + col0 + bj * HALF + 4 * n);
#pragma unroll
        for (int ai = 0; ai < 2; ++ai)
#pragma unroll
            for (int m = 0; m < 4; ++m) { const int row = row0 + ai * HALF + m * 16; bf16_t* rowp = O + (size_t)row * 8192 + col0;
                const float rs = __builtin_amdgcn_rsqf(ss[row] * (1.0f / 2048.0f) + 1e-6f);
#pragma unroll
                for (int bj = 0; bj < 2; ++bj) { f32x4 v0 = acc[ai][bj][m][0] * rs + bv[bj][0], v1 = acc[ai][bj][m][1] * rs + bv[bj][1];
#pragma unroll
                    for (int j = 0; j < 4; ++j) { const float a = fmaxf(v0[j], 0.f), b = fmaxf(v1[j], 0.f); v0[j] = a * a; v1[j] = b * b; }
                    u32x4 w; w.x = cvt_pk_bf16(v0[0], v0[1]); w.y = cvt_pk_bf16(v0[2], v0[3]); w.z = cvt_pk_bf16(v1[0], v1[1]); w.w = cvt_pk_bf16(v1[2], v1[3]);
                    *(u32x4*)(rowp + bj * HALF) = w; } }
    }
};
template <class Epi, class Sched, bool ALIGN_EPI = false, bool SP2 = false>
__device__ __forceinline__ void gemm_phase(PG8_LAS unsigned char* lds, const Gemm g, const Sched& S, const Epi& E) {
    int tid_l = threadIdx.x; asm volatile("" : "+v"(tid_l));
    const int tid = tid_l, wid = __builtin_amdgcn_readfirstlane(tid >> 6), lane = tid & 63, wr = wid >> 2, wc = wid & 3, fr = lane & 15, fq = lane >> 4;
    const int K = g.K, nt = K / BK;
    unsigned voffA[2], voffB[2];
#pragma unroll
    for (int i = 0; i < 2; ++i) { int R, C; stage_rc(tid * 16 + i * 8192, R, C); const int Rb = Epi::PERM ? ((R & ~31) + perm32(R & 31)) : R;
        voffA[i] = (unsigned)(R * K + C) * 2u; voffB[i] = (unsigned)(Rb * K + C) * 2u; }
    const size_t kstep = (size_t)(BK * 2);
    const size_t hstep = (size_t)HALF * K * 2;
    const size_t tstep = 2 * hstep;
    const unsigned ldsw = (unsigned)wid * 1024u;
    const int aoff = lds_byte(wr * 64 + fr, fq * 8), boff = lds_byte(wc * 32 + fr, fq * 8);
#define PG8_SA(b, h) (((b) * 2 + (h)) * HTB)
#define PG8_SB(b, h) ((4 + (b) * 2 + (h)) * HTB)
#define PG8_STAGE(bufoff, gbase, voff) do { _Pragma("unroll") for (int _i = 0; _i < 2; ++_i) \
        __builtin_amdgcn_global_load_lds((const unsigned*)((const char*)(gbase) + (voff)[_i]), (PG8_LAS unsigned*)(lds + (bufoff) + ldsw + _i * 8192), 16, 0, 0); } while (0)
#define PG8_LDA(dst, b, h) do { _Pragma("unroll") for (int m = 0; m < 4; ++m) _Pragma("unroll") for (int k = 0; k < 2; ++k) dst[m][k] = *(const PG8_LAS bf16x8*)(lds + PG8_SA(b, h) + aoff + m * 2048 + k * 1024); } while (0)
#define PG8_LDB(dst, b, h) do { _Pragma("unroll") for (int n = 0; n < 2; ++n) _Pragma("unroll") for (int k = 0; k < 2; ++k) dst[n][k] = *(const PG8_LAS bf16x8*)(lds + PG8_SB(b, h) + boff + n * 2048 + k * 1024); } while (0)
#define PG8_MMA(ai, bj, At, Bt) do { __builtin_amdgcn_s_setprio(1); _Pragma("unroll") for (int m = 0; m < 4; ++m) _Pragma("unroll") for (int n = 0; n < 2; ++n) _Pragma("unroll") for (int k = 0; k < 2; ++k) \
        acc[ai][bj][m][n] = __builtin_amdgcn_mfma_f32_16x16x32_bf16(Bt[n][k], At[m][k], acc[ai][bj][m][n], 0, 0, 0); __builtin_amdgcn_s_setprio(0); } while (0)
#define PG8_WAIT_V(n) asm volatile("s_waitcnt vmcnt(" #n ")" ::: "memory")
#define PG8_WAIT_L(n) asm volatile("s_waitcnt lgkmcnt(" #n ")" ::: "memory")
#define PG8_BAR __builtin_amdgcn_s_barrier()
#define PG8_SCHED __builtin_amdgcn_sched_barrier(0)
    Unit cur, nxt; int ui = 0;
    if (!S.next(0, cur)) return;
    f32x4 acc[2][2][4][2];
#pragma unroll
    for (int a = 0; a < 2; ++a)
#pragma unroll
        for (int b = 0; b < 2; ++b)
#pragma unroll
            for (int m = 0; m < 4; ++m)
#pragma unroll
                for (int n = 0; n < 2; ++n) acc[a][b][m][n] = (f32x4){0.f, 0.f, 0.f, 0.f};
    bf16x8 At[4][2], B0[2][2], B1[2][2];
    const char* cA = (const char*)g.A + (size_t)cur.pm * tstep; const char* cB = (const char*)g.Bt + (size_t)cur.pn * tstep;
    S.a_ready(cur);
    if constexpr (SP2) {
        PG8_STAGE(PG8_SB(0, 0), cB, voffB); PG8_STAGE(PG8_SB(0, 1), cB + hstep, voffB); PG8_STAGE(PG8_SA(0, 0), cA, voffA); PG8_STAGE(PG8_SA(0, 1), cA + hstep, voffA);
        if (wr == 1) PG8_BAR;
        PG8_WAIT_V(2); PG8_BAR;
        PG8_STAGE(PG8_SB(1, 0), cB + kstep, voffB); PG8_STAGE(PG8_SA(1, 0), cA + kstep, voffA); PG8_STAGE(PG8_SB(1, 1), cB + hstep + kstep, voffB);
        PG8_WAIT_V(6); PG8_BAR;
    } else {
        PG8_STAGE(PG8_SB(0, 0), cB, voffB); PG8_STAGE(PG8_SA(0, 0), cA, voffA); PG8_STAGE(PG8_SB(0, 1), cB + hstep, voffB); PG8_STAGE(PG8_SA(0, 1), cA + hstep, voffA);
        if (wr == 1) PG8_BAR;
        PG8_WAIT_V(4); PG8_BAR;
        PG8_STAGE(PG8_SB(1, 0), cB + kstep, voffB); PG8_STAGE(PG8_SA(1, 0), cA + kstep, voffA); PG8_STAGE(PG8_SB(1, 1), cB + hstep + kstep, voffB);
        PG8_WAIT_V(6); PG8_BAR;
    }
    for (;;) {
        const bool has_next = S.next(ui + 1, nxt);
        const char* nA = has_next ? (const char*)g.A + (size_t)nxt.pm * tstep : cA; const char* nB = has_next ? (const char*)g.Bt + (size_t)nxt.pn * tstep : cB;
        for (int t = 0; t < nt; t += 2) {
            const bool last = (t == nt - 2);
            const char* a1 = cA + (size_t)(t + 1) * kstep;
            const char* a2 = last ? nA : cA + (size_t)(t + 2) * kstep; const char* b2 = last ? nB : cB + (size_t)(t + 2) * kstep;
            const char* a3 = a2 + kstep; const char* b3 = b2 + kstep;
            if (last && has_next) S.a_ready(nxt);
            if constexpr (SP2) {
            PG8_LDB(B0, 0, 0); PG8_LDB(B1, 0, 1); PG8_SCHED; PG8_LDA(At, 0, 0); PG8_STAGE(PG8_SA(1, 1), a1 + hstep, voffA);
            PG8_WAIT_V(8); PG8_WAIT_L(0); PG8_BAR; PG8_MMA(0, 0, At, B0); PG8_MMA(0, 1, At, B1); PG8_BAR; PG8_SCHED;
            PG8_LDA(At, 0, 1); PG8_STAGE(PG8_SB(0, 0), b2, voffB); PG8_STAGE(PG8_SB(0, 1), b2 + hstep, voffB); PG8_STAGE(PG8_SA(0, 0), a2, voffA);
            PG8_WAIT_V(8); PG8_WAIT_L(0); PG8_BAR; PG8_MMA(1, 0, At, B0); PG8_MMA(1, 1, At, B1); PG8_BAR; PG8_SCHED;
            PG8_LDB(B0, 1, 0); PG8_LDB(B1, 1, 1); PG8_SCHED; PG8_LDA(At, 1, 0); PG8_STAGE(PG8_SA(0, 1), a2 + hstep, voffA);
            PG8_WAIT_V(8); PG8_WAIT_L(0); PG8_BAR; PG8_MMA(0, 0, At, B0); PG8_MMA(0, 1, At, B1); PG8_BAR; PG8_SCHED;
            PG8_LDA(At, 1, 1); PG8_STAGE(PG8_SB(1, 0), b3, voffB); PG8_STAGE(PG8_SB(1, 1), b3 + hstep, voffB); PG8_STAGE(PG8_SA(1, 0), a3, voffA);
            PG8_WAIT_V(8); PG8_WAIT_L(0); PG8_BAR; PG8_MMA(1, 0, At, B0); PG8_MMA(1, 1, At, B1); PG8_BAR; PG8_SCHED;
            } else {
            PG8_LDB(B0, 0, 0); PG8_SCHED; PG8_LDA(At, 0, 0); PG8_STAGE(PG8_SA(1, 1), a1 + hstep, voffA);
            PG8_WAIT_L(8); PG8_BAR; PG8_WAIT_L(0); PG8_MMA(0, 0, At, B0); PG8_BAR; PG8_SCHED;
            PG8_LDB(B1, 0, 1); PG8_STAGE(PG8_SB(0, 0), b2, voffB);
            PG8_BAR; PG8_WAIT_L(0); PG8_MMA(0, 1, At, B1); PG8_BAR;
            PG8_LDA(At, 0, 1); PG8_STAGE(PG8_SA(0, 0), a2, voffA);
            PG8_BAR; PG8_WAIT_L(0); PG8_MMA(1, 0, At, B0); PG8_BAR; PG8_SCHED;
            PG8_STAGE(PG8_SB(0, 1), b2 + hstep, voffB);
            PG8_WAIT_V(6); PG8_BAR; PG8_MMA(1, 1, At, B1); PG8_BAR;
            PG8_LDB(B0, 1, 0); PG8_SCHED; PG8_LDA(At, 1, 0); PG8_STAGE(PG8_SA(0, 1), a2 + hstep, voffA);
            PG8_WAIT_L(8); PG8_BAR; PG8_WAIT_L(0); PG8_MMA(0, 0, At, B0); PG8_BAR; PG8_SCHED;
            PG8_LDB(B1, 1, 1); PG8_STAGE(PG8_SB(1, 0), b3, voffB);
            PG8_BAR; PG8_WAIT_L(0); PG8_MMA(0, 1, At, B1); PG8_BAR;
            PG8_LDA(At, 1, 1); PG8_STAGE(PG8_SA(1, 0), a3, voffA);
            PG8_BAR; PG8_WAIT_L(0); PG8_MMA(1, 0, At, B0); PG8_BAR; PG8_SCHED;
            PG8_STAGE(PG8_SB(1, 1), b3 + hstep, voffB);
            PG8_WAIT_V(6); PG8_BAR; PG8_MMA(1, 1, At, B1); PG8_BAR;
            }
        }
        if constexpr (ALIGN_EPI) { if (wr == 0) PG8_BAR; }
        if constexpr (!Epi::AFTER_DRAIN) { E(acc, cur, wr, wc, fr, fq); S.done(cur); }
        if (!has_next) break;
#pragma unroll
        for (int a = 0; a < 2; ++a)
#pragma unroll
            for (int b = 0; b < 2; ++b)
#pragma unroll
                for (int m = 0; m < 4; ++m)
#pragma unroll
                    for (int n = 0; n < 2; ++n) acc[a][b][m][n] = (f32x4){0.f, 0.f, 0.f, 0.f};
        cur = nxt; cA = nA; cB = nB; ++ui;
        if constexpr (ALIGN_EPI) { if (wr == 1) PG8_BAR; }
    }
    PG8_WAIT_V(0);
    if constexpr (!ALIGN_EPI) { if (wr == 0) PG8_BAR; }
    PG8_BAR;
    if constexpr (Epi::AFTER_DRAIN) { E.fused(acc, cur, wr, wc, fr, fq, lds, wid, lane); S.done(cur); }
#undef PG8_SA
#undef PG8_SB
#undef PG8_STAGE
#undef PG8_LDA
#undef PG8_LDB
#undef PG8_MMA
#undef PG8_WAIT_V
#undef PG8_WAIT_L
#undef PG8_BAR
#undef PG8_SCHED
}
}
using pg8::bflo; using pg8::bfhi;
#define cvt_pk_bf16_c pg8::cvt_pk_bf16
using pg8::bf16_t; using pg8::bf16x8; using pg8::f32x4; using pg8::u32x4;
#define LAS __attribute__((address_space(3)))
typedef short s16x4 __attribute__((ext_vector_type(4)));
typedef unsigned u32x2 __attribute__((ext_vector_type(2)));

constexpr int NB = 2, SEQ = 16384, T = NB * SEQ, D = 2048, DA = 1024, DB = 1536, DBO = 512, DFF = 8192, INC = 10752, NH = 12;
constexpr float EPS = 1e-6f;
constexpr size_t MiB = 1u << 20;
constexpr size_t WS_MOD = 1 * MiB;
constexpr size_t WS_LSE = 2 * MiB;
constexpr size_t WS_WSB = 4 * MiB;
constexpr size_t WS_VST = 4 * MiB + 512 * 1024;
constexpr size_t WS_W = 5 * MiB;
constexpr size_t WO_IN = 0, WO_OA = 42 * MiB, WO_OB = 46 * MiB, WO_OUT = 48 * MiB, WO_W1 = 56 * MiB, WO_W2 = 88 * MiB;
constexpr size_t WS_H = 125 * MiB;
constexpr size_t WS_BIG = 253 * MiB;
constexpr size_t BO_U = 0, BO_VA = 64 * MiB, BO_Q = 128 * MiB, BO_K = 224 * MiB, BO_V = 320 * MiB, BO_SGA = 416 * MiB, BO_SGB = 544 * MiB;
constexpr size_t WS_L1 = WS_BIG + 672 * MiB;
constexpr size_t WS_END = WS_L1 + 88 * MiB;
constexpr size_t WS_C1 = WS_MOD + 256 * 1024;
constexpr size_t WS_CIN = WS_MOD + 384 * 1024;
constexpr size_t WS_SS = WS_MOD + 512 * 1024;
struct WOff { size_t in, oa, ob, out, w1, w2; };
__device__ __forceinline__ WOff woff(int l) { WOff w;
    w.in = l == 0 ? WS_W + WO_IN : WS_L1; w.oa = l == 0 ? WS_W + WO_OA : WS_L1 + 74 * MiB; w.ob = l == 0 ? WS_W + WO_OB : WS_L1 + 78 * MiB;
    w.out = l == 0 ? WS_W + WO_OUT : WS_L1 + 80 * MiB; w.w1 = l == 0 ? WS_W + WO_W1 : WS_L1 + 42 * MiB; w.w2 = l == 0 ? WS_W + WO_W2 : WS_W + WO_IN; return w; }
constexpr int LDS_BYTES = 135168;
constexpr int NPHASE = 20;

struct Args { const float* in[20]; float* out; unsigned char* ws; };

__device__ __forceinline__ float wave_sum(float v) {
#pragma unroll
    for (int o = 1; o < 64; o <<= 1) v += __shfl_xor(v, o);
    return v;
}
__device__ __forceinline__ unsigned f2bf(float f) { unsigned u = __float_as_uint(f); return (u + 0x7fffu + ((u >> 16) & 1u)) >> 16; }
__device__ __forceinline__ unsigned pk2(float lo, float hi) { return f2bf(lo) | (f2bf(hi) << 16); }
__device__ __forceinline__ unsigned off_b(unsigned row, unsigned ch) { return 256u * row + 16u * (ch ^ (((row & 3u) << 2) | ((row >> 2) & 3u))); }

__device__ __forceinline__ void transpose_item(const float* W, int K, int N, bf16_t* WT, int item, int lane) {
    const int nblk = N / 256, kb = item / nblk, nb = item % nblk, k0 = 16 * kb, n0 = 256 * nb + 4 * lane;
    const float* src = W + (size_t)k0 * N + n0;
    f32x4 v[16];
#pragma unroll
    for (int i = 0; i < 16; ++i) v[i] = __builtin_nontemporal_load((const f32x4*)(src + (size_t)i * N));
#pragma unroll
    for (int c = 0; c < 4; ++c) { bf16_t* dst = WT + (size_t)(n0 + c) * K + k0;
        u32x4 lo, hi;
        lo.x = cvt_pk_bf16_c(v[0][c], v[1][c]); lo.y = cvt_pk_bf16_c(v[2][c], v[3][c]); lo.z = cvt_pk_bf16_c(v[4][c], v[5][c]); lo.w = cvt_pk_bf16_c(v[6][c], v[7][c]);
        hi.x = cvt_pk_bf16_c(v[8][c], v[9][c]); hi.y = cvt_pk_bf16_c(v[10][c], v[11][c]); hi.z = cvt_pk_bf16_c(v[12][c], v[13][c]); hi.w = cvt_pk_bf16_c(v[14][c], v[15][c]);
        *(u32x4*)dst = lo; *(u32x4*)(dst + 8) = hi; }
}
__device__ __forceinline__ void convert_layer_weights(const float* const* inp, unsigned char* ws, int l, LAS unsigned char* lds, int gw, int NGW, int wave, int lane) {
    const WOff wo = woff(l);
    const float* w_in = inp[5] + (size_t)l * D * INC;   const float* w_oa = inp[11] + (size_t)l * DA * D; const float* w_ob = inp[12] + (size_t)l * DBO * D;
    const float* w_out = inp[13] + (size_t)l * D * D;   const float* w1 = inp[15] + (size_t)l * D * DFF;  const float* w2 = inp[17] + (size_t)l * DFF * D;
    constexpr int I_IN = (D / 16) * (INC / 256), I_OA = (DA / 16) * (D / 256), I_OB = (DBO / 16) * (D / 256), I_OUT = (D / 16) * (D / 256), I_1 = (D / 16) * (DFF / 256), I_2 = (DFF / 16) * (D / 256);
    constexpr int NITEMS = I_IN + I_OA + I_OB + I_OUT + I_1 + I_2;
    for (int it = gw; it < NITEMS; it += NGW) {
        int r = it;
        if (r < I_IN) { transpose_item(w_in, D, INC, (bf16_t*)(ws + wo.in), r, lane); continue; } r -= I_IN;
        if (r < I_OA) { transpose_item(w_oa, DA, D, (bf16_t*)(ws + wo.oa), r, lane); continue; } r -= I_OA;
        if (r < I_OB) { transpose_item(w_ob, DBO, D, (bf16_t*)(ws + wo.ob), r, lane); continue; } r -= I_OB;
        if (r < I_OUT) { transpose_item(w_out, D, D, (bf16_t*)(ws + wo.out), r, lane); continue; } r -= I_OUT;
        if (r < I_1) { transpose_item(w1, D, DFF, (bf16_t*)(ws + wo.w1), r, lane); continue; } r -= I_1;
        transpose_item(w2, DFF, D, (bf16_t*)(ws + wo.w2), r, lane);
    }
}
template <bool SILU> __device__ __forceinline__ void gemv_item(const float* W, size_t ldw, const float* x0, const float* x1, const float* bias, float* out0, float* out1, int col0, LAS unsigned char* lds, int tid, int wave, int lane) {
    const int l5 = lane & 31, rg = wave * 2 + (lane >> 5), k0 = rg * 128;
    const float* Wp = W + (size_t)k0 * ldw + col0 + 4 * l5;
    f32x4 a0 = {0.f, 0.f, 0.f, 0.f}, a1 = {0.f, 0.f, 0.f, 0.f};
#pragma unroll 8
    for (int k = 0; k < 128; ++k) {
        const f32x4 w = __builtin_nontemporal_load((const f32x4*)(Wp + (size_t)k * ldw));
        float s0 = x0[k0 + k], s1 = x1[k0 + k];
        if (SILU) { s0 = s0 * __builtin_amdgcn_rcpf(1.0f + __expf(-s0)); s1 = s1 * __builtin_amdgcn_rcpf(1.0f + __expf(-s1)); }
        a0 += w * s0; a1 += w * s1;
    }
    LAS float* red = (LAS float*)lds;
    __syncthreads();
    *(LAS f32x4*)(red + (rg * 2 + 0) * 128 + l5 * 4) = a0;
    *(LAS f32x4*)(red + (rg * 2 + 1) * 128 + l5 * 4) = a1;
    __syncthreads();
    if (tid < 256) { const int b = tid >> 7, col = tid & 127; float sm = 0.f;
#pragma unroll
      for (int w = 0; w < 16; ++w) sm += red[(w * 2 + b) * 128 + col];
      (b ? out1 : out0)[col0 + col] = sm + bias[col0 + col]; }
    __syncthreads();
}
__device__ __forceinline__ void norm_phase(const float* x, const float* g, const float* shift, const float* scale, bf16_t* H, int gw, int NGW, int lane) {
    for (int b = 0; b < NB; ++b) {
        f32x4 ca[4][2], cs[4][2];
#pragma unroll
        for (int j = 0; j < 4; ++j)
#pragma unroll
            for (int h = 0; h < 2; ++h) { const int col = j * 512 + lane * 8 + h * 4;
                const f32x4 gg = *(const f32x4*)(g + col), sc = *(const f32x4*)(scale + b * 12288 + col);
                ca[j][h] = gg * (sc + 1.0f); cs[j][h] = *(const f32x4*)(shift + b * 12288 + col); }
        for (int r = gw; r < SEQ; r += NGW) {
            const float* xr = x + (size_t)(b * SEQ + r) * D;
            f32x4 v[4][2]; float ss = 0.f;
#pragma unroll
            for (int j = 0; j < 4; ++j)
#pragma unroll
                for (int h = 0; h < 2; ++h) { v[j][h] = __builtin_nontemporal_load((const f32x4*)(xr + j * 512 + lane * 8 + h * 4)); const f32x4 q = v[j][h] * v[j][h]; ss += (q[0] + q[1]) + (q[2] + q[3]); }
            const float rstd = 1.0f / sqrtf(wave_sum(ss) * (1.0f / D) + EPS);
            bf16_t* hr = H + (size_t)(b * SEQ + r) * D;
#pragma unroll
            for (int j = 0; j < 4; ++j) { const f32x4 o0 = v[j][0] * rstd * ca[j][0] + cs[j][0], o1 = v[j][1] * rstd * ca[j][1] + cs[j][1];
                u32x4 w; w.x = pk2(o0[0], o0[1]); w.y = pk2(o0[2], o0[3]); w.z = pk2(o1[0], o1[1]); w.w = pk2(o1[2], o1[3]);
                *(u32x4*)(hr + j * 512 + lane * 8) = w; }
        }
    }
}
__device__ __forceinline__ void final_norm_phase(const bf16_t* xb, const float* ssq, float* out, const float* g, int gw, int NGW, int lane) {
    f32x4 cg_[4][2];
#pragma unroll
    for (int j = 0; j < 4; ++j)
#pragma unroll
        for (int h = 0; h < 2; ++h) cg_[j][h] = *(const f32x4*)(g + j * 512 + lane * 8 + h * 4);
    for (int r = gw; r < T; r += NGW) {
        const bf16_t* xr = xb + (size_t)r * D; float* orow = out + (size_t)r * D;
        u32x4 v[4];
#pragma unroll
        for (int j = 0; j < 4; ++j) v[j] = __builtin_nontemporal_load((const u32x4*)(xr + j * 512 + lane * 8));
        const float rstd = 1.0f / sqrtf(ssq[r] * (1.0f / D) + EPS);
#pragma unroll
        for (int j = 0; j < 4; ++j) { const f32x4 a = {bflo(v[j].x), bfhi(v[j].x), bflo(v[j].y), bfhi(v[j].y)}, b = {bflo(v[j].z), bfhi(v[j].z), bflo(v[j].w), bfhi(v[j].w)};
            *(f32x4*)(orow + j * 512 + lane * 8) = a * rstd * cg_[j][0]; *(f32x4*)(orow + j * 512 + lane * 8 + 4) = b * rstd * cg_[j][1]; }
    }
}
__device__ __forceinline__ s16x4 tr_read(LAS unsigned char* p) { return __builtin_amdgcn_ds_read_tr16_b64_v4i16((LAS s16x4*)p); }
__device__ __forceinline__ void attn_item(bf16_t* Q, const bf16_t* Kg, const bf16_t* Vg, float* lse, int item, int par, bool reuse, LAS unsigned char* lds, int tid, int wave, int lane) {
    const int n = item & 127, bh = item >> 7, h = bh % NH, b = bh / NH, grp = h >> 2;
    const int dsh = 2 * grp, d = 1 << dsh, nbsh = 7 - dsh;
    const int r = n >> nbsh, nblk = n & ((1 << nbsh) - 1);
    const int fr = lane & 15, fq = lane >> 4;
    LAS unsigned char* Kl = lds; LAS unsigned char* Vl = lds + 65536;
    __syncthreads();
    if (!reuse) {
        u32x4 kr[8], vr[8];
#pragma unroll
        for (int i = 0; i < 8; ++i) { const int id = tid + 512 * i, j = id >> 4, ch = id & 15; int mk = (nblk - 1) * 128 + j; mk = mk < 0 ? 0 : mk;
            const size_t go = ((size_t)(b * SEQ + (mk << dsh) + r)) * DB + h * 128 + ch * 8;
            kr[i] = *(const u32x4*)(Kg + go); vr[i] = *(const u32x4*)(Vg + go); }
#pragma unroll
        for (int i = 0; i < 8; ++i) { const int id = tid + 512 * i, j = id >> 4, ch = id & 15; const unsigned o = off_b((j + 128 * par) & 255, ch);
            *(LAS u32x4*)(Kl + o) = kr[i]; *(LAS u32x4*)(Vl + o) = vr[i]; }
    } else {
        u32x4 kr[4], vr[4];
#pragma unroll
        for (int i = 0; i < 4; ++i) { const int id = tid + 512 * i, j = 128 + (id >> 4), ch = id & 15; const int mk = (nblk - 1) * 128 + j;
            const size_t go = ((size_t)(b * SEQ + (mk << dsh) + r)) * DB + h * 128 + ch * 8;
            kr[i] = *(const u32x4*)(Kg + go); vr[i] = *(const u32x4*)(Vg + go); }
#pragma unroll
        for (int i = 0; i < 4; ++i) { const int id = tid + 512 * i, j = 128 + (id >> 4), ch = id & 15; const unsigned o = off_b((j + 128 * par) & 255, ch);
            *(LAS u32x4*)(Kl + o) = kr[i]; *(LAS u32x4*)(Vl + o) = vr[i]; }
    }
    const int qi = 16 * wave + fr;
    const size_t qrow = (size_t)(b * SEQ + (((nblk << 7) + qi) << dsh) + r);
    bf16x8 qf[4];
#pragma unroll
    for (int s = 0; s < 4; ++s) qf[s] = *(const bf16x8*)(Q + qrow * DB + h * 128 + 32 * s + 8 * fq);
    __syncthreads();
    const int T0 = 2 * (wave >> 1);
    const unsigned xk = ((fr & 3) << 2) | ((fr >> 2) & 3);
    f32x4 sacc[10];
#pragma unroll
    for (int kt = 0; kt < 10; ++kt) { sacc[kt] = (f32x4){0.f, 0.f, 0.f, 0.f};
#pragma unroll
        for (int s = 0; s < 4; ++s) { const bf16x8 kf = *(const LAS bf16x8*)(Kl + 4096u * ((T0 + kt + 8 * par) & 15) + 256u * fr + 16u * ((4 * s + fq) ^ xk));
            sacc[kt] = __builtin_amdgcn_mfma_f32_16x16x32_bf16(kf, qf[s], sacc[kt], 0, 0, 0); } }
    const float slope2 = exp2f(-8.0f * (float)(h + 1) / 12.0f) * (float)d * 1.4426950409f;
    const float sc2 = 0.08838834764831845f * 1.4426950409f;
    float mx = -3.0e38f;
    const int dist0 = 128 + qi - 16 * T0 - 4 * fq;
    const unsigned ub = (nblk > 0) ? 128u : (unsigned)qi;
#pragma unroll
    for (int kt = 0; kt < 10; ++kt)
#pragma unroll
        for (int e = 0; e < 4; ++e) { const int dist = dist0 - (16 * kt + e);
            const float s2 = sacc[kt][e] * sc2 - slope2 * (float)dist;
            sacc[kt][e] = ((unsigned)dist <= ub) ? s2 : -3.0e38f; mx = fmaxf(mx, sacc[kt][e]); }
    mx = fmaxf(mx, __shfl_xor(mx, 16)); mx = fmaxf(mx, __shfl_xor(mx, 32));
    float lsum = 0.f;
#pragma unroll
    for (int kt = 0; kt < 10; ++kt)
#pragma unroll
        for (int e = 0; e < 4; ++e) { const float p = __builtin_amdgcn_exp2f(sacc[kt][e] - mx); sacc[kt][e] = p; lsum += p; }
    lsum += __shfl_xor(lsum, 16); lsum += __shfl_xor(lsum, 32);
    bf16x8 pf[5];
#pragma unroll
    for (int ks = 0; ks < 5; ++ks) { u32x4 w; w.x = cvt_pk_bf16_c(sacc[2 * ks][0], sacc[2 * ks][1]); w.y = cvt_pk_bf16_c(sacc[2 * ks][2], sacc[2 * ks][3]);
        w.z = cvt_pk_bf16_c(sacc[2 * ks + 1][0], sacc[2 * ks + 1][1]); w.w = cvt_pk_bf16_c(sacc[2 * ks + 1][2], sacc[2 * ks + 1][3]); pf[ks] = __builtin_bit_cast(bf16x8, w); }
    const int q4 = fr >> 2, p4 = fr & 3;
    const unsigned xv = (q4 << 2) | fq;
    LAS unsigned char* vbase = Vl + 256u * (4 * fq + q4) + 8u * (p4 & 1);
    f32x4 oacc[8];
    const float inv = 1.0f / lsum;
    bf16_t* orow = Q + qrow * DB + h * 128 + 4 * fq;
#pragma unroll
    for (int c = 0; c < 8; ++c) { oacc[c] = (f32x4){0.f, 0.f, 0.f, 0.f};
        const unsigned co = 16u * ((2 * c + (p4 >> 1)) ^ xv);
#pragma unroll
        for (int ks = 0; ks < 5; ++ks) { const s16x4 lo = tr_read(vbase + co + 4096u * ((T0 + 2 * ks + 8 * par) & 15)), hi = tr_read(vbase + co + 4096u * ((T0 + 2 * ks + 1 + 8 * par) & 15));
            const bf16x8 vf = __builtin_shufflevector(lo, hi, 0, 1, 2, 3, 4, 5, 6, 7);
            oacc[c] = __builtin_amdgcn_mfma_f32_16x16x32_bf16(vf, pf[ks], oacc[c], 0, 0, 0); }
        u32x2 w; w.x = cvt_pk_bf16_c(oacc[c][0] * inv, oacc[c][1] * inv); w.y = cvt_pk_bf16_c(oacc[c][2] * inv, oacc[c][3] * inv);
        *(u32x2*)(orow + 16 * c) = w; }
    if (fq == 0) lse[qrow * NH + h] = (mx + __builtin_amdgcn_logf(lsum)) * 0.6931471805599453f;
}
__device__ __forceinline__ void gate_item(bf16_t* U, const bf16_t* VA, const bf16_t* WsB, const float* gv, const float* bv, const float* bs, const float* vst, int chunk, LAS unsigned char* lds, int tid, int wave, int lane) {
    const int fr = lane & 15, fq = lane >> 4;
    LAS unsigned char* Vi = lds; LAS unsigned char* Wi = lds + 32768; LAS float* st = (LAS float*)(lds + 65536);
    __syncthreads();
    if (tid < 128) { const float s1 = vst[2 * (size_t)(chunk * 128 + tid)], s2 = vst[2 * (size_t)(chunk * 128 + tid) + 1];
        const float mean = s1 * (1.0f / DA), var = fmaxf(s2 * (1.0f / DA) - mean * mean, 0.f);
        st[2 * tid] = mean; st[2 * tid + 1] = 1.0f / sqrtf(var + EPS); }
    const int ch = tid & 15, s0 = tid >> 4, q4 = fr >> 2, p4 = fr & 3;
    u32x4 pv[4], pw[4]; f32x4 g0, g1, b0, b1;
#define GATE_LOAD(g) do { _Pragma("unroll") for (int i = 0; i < 4; ++i) { pv[i] = *(const u32x4*)(VA + (size_t)(chunk * 128 + s0 + 32 * i) * DA + (g) * 128 + ch * 8); pw[i] = *(const u32x4*)(WsB + (size_t)((g) * 128 + s0 + 32 * i) * 128 + ch * 8); } \
        g0 = *(const f32x4*)(gv + (g) * 128 + ch * 8); g1 = *(const f32x4*)(gv + (g) * 128 + ch * 8 + 4); b0 = *(const f32x4*)(bv + (g) * 128 + ch * 8); b1 = *(const f32x4*)(bv + (g) * 128 + ch * 8 + 4); } while (0)
    GATE_LOAD(0);
#pragma unroll 1
    for (int g = 0; g < 8; ++g) {
        __syncthreads();
#pragma unroll
        for (int i = 0; i < 4; ++i) { const int s = s0 + 32 * i; const u32x4 a = pv[i];
            const float mean = st[2 * s], rstd = st[2 * s + 1];
            u32x4 w; w.x = cvt_pk_bf16_c((bflo(a.x) - mean) * rstd * g0[0] + b0[0], (bfhi(a.x) - mean) * rstd * g0[1] + b0[1]); w.y = cvt_pk_bf16_c((bflo(a.y) - mean) * rstd * g0[2] + b0[2], (bfhi(a.y) - mean) * rstd * g0[3] + b0[3]);
            w.z = cvt_pk_bf16_c((bflo(a.z) - mean) * rstd * g1[0] + b1[0], (bfhi(a.z) - mean) * rstd * g1[1] + b1[1]); w.w = cvt_pk_bf16_c((bflo(a.w) - mean) * rstd * g1[2] + b1[2], (bfhi(a.w) - mean) * rstd * g1[3] + b1[3]);
            *(LAS u32x4*)(Vi + off_b(s, ch)) = w;
            *(LAS u32x4*)(Wi + off_b(s, ch)) = pw[i]; }
        if (g < 7) GATE_LOAD(g + 1);
        const float bsv = bs[g * 128 + 16 * wave + fr];
        bf16_t* ur = U + (size_t)(chunk * 128 + 16 * wave + fr) * DA + g * 128 + 4 * fq;
        u32x2 uu[8];
#pragma unroll
        for (int c = 0; c < 8; ++c) uu[c] = *(const u32x2*)(ur + 16 * c);
        __syncthreads();
        f32x4 acc[8];
#pragma unroll
        for (int c = 0; c < 8; ++c) acc[c] = (f32x4){0.f, 0.f, 0.f, 0.f};
#pragma unroll 1
        for (int ks = 0; ks <= (wave >> 1); ++ks) {
            const bf16x8 wf = *(const LAS bf16x8*)(Wi + off_b(16 * wave + fr, 4 * ks + fq));
#pragma unroll
            for (int c = 0; c < 8; ++c) {
                const s16x4 lo = tr_read(Vi + off_b(32 * ks + 8 * fq + q4, 2 * c + (p4 >> 1)) + 8 * (p4 & 1)), hi = tr_read(Vi + off_b(32 * ks + 8 * fq + 4 + q4, 2 * c + (p4 >> 1)) + 8 * (p4 & 1));
                const bf16x8 vf = __builtin_shufflevector(lo, hi, 0, 1, 2, 3, 4, 5, 6, 7);
                acc[c] = __builtin_amdgcn_mfma_f32_16x16x32_bf16(vf, wf, acc[c], 0, 0, 0); } }
#pragma unroll
        for (int c = 0; c < 8; ++c) { const u32x2 u2 = uu[c];
            u32x2 w; w.x = cvt_pk_bf16_c(bflo(u2.x) * (acc[c][0] + bsv), bfhi(u2.x) * (acc[c][1] + bsv)); w.y = cvt_pk_bf16_c(bflo(u2.y) * (acc[c][2] + bsv), bfhi(u2.y) * (acc[c][3] + bsv));
            *(u32x2*)(ur + 16 * c) = w; }
    }
#undef GATE_LOAD
}
__device__ __forceinline__ void combine_phase(const bf16_t* O, const float* lse, bf16_t* YB, int gw, int NGW, int lane) {
    const int hg = lane >> 4, c8 = (lane & 15) * 8;
    for (int t = gw; t < T; t += NGW) {
        const float l0 = lse[(size_t)t * NH + hg], l1 = lse[(size_t)t * NH + 4 + hg], l2 = lse[(size_t)t * NH + 8 + hg];
        const float m = fmaxf(l0, fmaxf(l1, l2)); float w0 = __expf(l0 - m), w1 = __expf(l1 - m), w2 = __expf(l2 - m); const float inv = 1.0f / (w0 + w1 + w2); w0 *= inv; w1 *= inv; w2 *= inv;
        const bf16_t* op = O + (size_t)t * DB + hg * 128 + c8;
        const u32x4 a = __builtin_nontemporal_load((const u32x4*)op), b = __builtin_nontemporal_load((const u32x4*)(op + 512)), c = __builtin_nontemporal_load((const u32x4*)(op + 1024));
        u32x4 w;
        w.x = pk2(w0 * bflo(a.x) + w1 * bflo(b.x) + w2 * bflo(c.x), w0 * bfhi(a.x) + w1 * bfhi(b.x) + w2 * bfhi(c.x));
        w.y = pk2(w0 * bflo(a.y) + w1 * bflo(b.y) + w2 * bflo(c.y), w0 * bfhi(a.y) + w1 * bfhi(b.y) + w2 * bfhi(c.y));
        w.z = pk2(w0 * bflo(a.z) + w1 * bflo(b.z) + w2 * bflo(c.z), w0 * bfhi(a.z) + w1 * bfhi(b.z) + w2 * bfhi(c.z));
        w.w = pk2(w0 * bflo(a.w) + w1 * bflo(b.w) + w2 * bflo(c.w), w0 * bfhi(a.w) + w1 * bfhi(b.w) + w2 * bfhi(c.w));
        *(u32x4*)(YB + (size_t)t * DBO + hg * 128 + c8) = w;
    }
}

#define XB_TMO      128
#define XB_XCNT(j)  (256  + 64 * (j))
#define XB_XSUB(j)  (1280 + 64 * (j))
#define XB_XGEN(j)  (2304 + 64 * (j))
#define XB_TOP      3328
#define XB_TOPGEN   3392
#define XCD_BAR_WORDS 3456
#define XB_SPIN_CAP (1u << 18)

__device__ __forceinline__ unsigned xb_ld(unsigned* p)              { return __hip_atomic_load(p, __ATOMIC_RELAXED, __HIP_MEMORY_SCOPE_AGENT); }
__device__ __forceinline__ unsigned xb_add(unsigned* p, unsigned v) { return __hip_atomic_fetch_add(p, v, __ATOMIC_RELAXED, __HIP_MEMORY_SCOPE_AGENT); }
__device__ __forceinline__ unsigned xb_xcc_id() { return (unsigned)__builtin_amdgcn_s_getreg((3 << 11) | 20) & 0xFu; }
#define XB_SPIN(cond, bar) do { unsigned _sp = 0; while (cond) { __builtin_amdgcn_s_sleep(1); \
    if ((++_sp & 255u) == 0u) { if (xb_ld(&(bar)[XB_TMO])) break; if (_sp > XB_SPIN_CAP) { atomicAdd(&(bar)[XB_TMO], 1u); break; } } } } while (0)

struct XcdBarrier {
    unsigned* bar; unsigned x;
    volatile LAS unsigned* st;
};

__device__ __forceinline__ XcdBarrier xcd_barrier_post(unsigned* bar, volatile LAS unsigned* st) {
    XcdBarrier b; b.bar = bar; b.x = xb_xcc_id(); b.st = st;
    if (threadIdx.x == 0) (void)xb_add(&bar[XB_XCNT(b.x)], 1u);
    return b;
}
__device__ __forceinline__ void xcd_barrier_complete(unsigned* bar, unsigned x, unsigned& nloc, unsigned& nx) {
    const unsigned G = gridDim.x * gridDim.y * gridDim.z;
    unsigned sum, cnt, mine, sp = 0u;
    for (;;) {
        sum = 0u; cnt = 0u; mine = 0u;
#pragma unroll
        for (unsigned j = 0; j < 16; ++j) { const unsigned c = xb_ld(&bar[XB_XCNT(j)]); sum += c; cnt += (c > 0u) ? 1u : 0u; mine = (j == x) ? c : mine; }
        if (sum == G) break;
        __builtin_amdgcn_s_sleep(1);
        if ((++sp & 255u) == 0u) { if (xb_ld(&bar[XB_TMO])) break; if (sp > XB_SPIN_CAP) { atomicAdd(&bar[XB_TMO], 1u); break; } }
    }
    nloc = mine > 0u ? mine : 1u; nx = cnt > 0u ? cnt : 1u;
}

__device__ __forceinline__ void xcd_barrier(const XcdBarrier& b) {
    asm volatile("s_waitcnt vmcnt(0)" ::: "memory");
    __syncthreads();
    if (threadIdx.x == 0) {
        unsigned* bar = b.bar;
        __builtin_amdgcn_s_waitcnt(0);
        unsigned nloc = b.st[0], nx = b.st[1];
        if (nloc == 0u) { xcd_barrier_complete(bar, b.x, nloc, nx); b.st[0] = nloc; b.st[1] = nx; }
        const unsigned old = xb_add(&bar[XB_XSUB(b.x)], 1u);
        const unsigned gen = old / nloc;
        if (old + 1u == (gen + 1u) * nloc) {
            __builtin_amdgcn_fence(__ATOMIC_RELEASE, "agent");
            asm volatile("s_waitcnt vmcnt(0)" ::: "memory");
            const unsigned og = xb_add(&bar[XB_TOP], 1u);
            const unsigned tg = og / nx;
            if (og + 1u == (tg + 1u) * nx) xb_add(&bar[XB_TOPGEN], 1u);
            else XB_SPIN(xb_ld(&bar[XB_TOPGEN]) == tg, bar);
            __builtin_amdgcn_fence(__ATOMIC_ACQUIRE, "agent");
            xb_add(&bar[XB_XGEN(b.x)], 1u);
            asm volatile("s_waitcnt vmcnt(0)" ::: "memory");
        } else {
            XB_SPIN(xb_ld(&bar[XB_XGEN(b.x)]) == gen, bar);
            __builtin_amdgcn_fence(__ATOMIC_ACQUIRE, "agent");
            asm volatile("s_waitcnt vmcnt(0)" ::: "memory");
        }
    }
    __syncthreads();
}

#define CG_SYNC() do { asm volatile("s_waitcnt vmcnt(0)" ::: "memory");     \
    cg::this_grid().sync(); \
    __builtin_amdgcn_fence(__ATOMIC_ACQUIRE, "agent");                        \
    asm volatile("s_waitcnt vmcnt(0)" ::: "memory"); } while (0)
#define GRID_SYNC() do { XcdBarrier xb_; xb_.bar = (unsigned*)args.ws; xb_.x = xb_xcc_id(); xb_.st = (volatile LAS unsigned*)(lds + 131072 + 64); xcd_barrier(xb_); } while (0)
#define PHASE_VARS \
    int tid = threadIdx.x; asm volatile("" : "+v"(tid)); \
    const int lane = tid & 63, wave = __builtin_amdgcn_readfirstlane(tid >> 6), gw = bx * 8 + wave; (void)lane; (void)gw; \
    const float* const* inp = (const float* const*)__builtin_amdgcn_kernarg_segment_ptr(); asm volatile("" : "+s"(inp));     \
    unsigned char* ws = args.ws; asm volatile("" : "+s"(ws)); \
    float* xo = args.out; asm volatile("" : "+s"(xo)); (void)xo; bf16_t* XB = (bf16_t*)xo; (void)XB;     \
    float* mod = (float*)(ws + WS_MOD); float* lse = (float*)(ws + WS_LSE); bf16_t* WsB = (bf16_t*)(ws + WS_WSB); (void)mod; (void)lse; (void)WsB; \
    bf16_t* Wb = (bf16_t*)(ws + WS_W); bf16_t* H = (bf16_t*)(ws + WS_H); unsigned char* big = ws + WS_BIG; (void)Wb; (void)H; \
    bf16_t *U = (bf16_t*)(big + BO_U), *VA = (bf16_t*)(big + BO_VA), *Qb = (bf16_t*)(big + BO_Q), *Kb = (bf16_t*)(big + BO_K), *Vb = (bf16_t*)(big + BO_V), *SGA = (bf16_t*)(big + BO_SGA), *SGB = (bf16_t*)(big + BO_SGB); \
    (void)U; (void)VA; (void)Qb; (void)Kb; (void)Vb; (void)SGA; (void)SGB; \
    bf16_t* MRG = Kb; bf16_t* HID = (bf16_t*)big; bf16_t* YB = H; (void)MRG; (void)HID; (void)YB;
#define WPTR(off) ((const bf16_t*)((unsigned char*)Wb + (off)))

template <int L> __device__ __forceinline__ void layer_phases(const Args& args, LAS unsigned char* lds, const int G, const int bx, const int NGW) {
    constexpr int l = L;
    if (l == 0) {
        { PHASE_VARS
          for (int it = bx; it < 212; it += G) {
              if (it < 128) { const int ll = it >> 6, cb = it & 63; const float* sh = mod + (size_t)ll * 2 * 12288 + 3 * D; float* c1 = (float*)(ws + WS_C1) + (size_t)ll * 2 * 8192;
                  gemv_item<false>(inp[15] + (size_t)ll * D * DFF, DFF, sh, sh + 12288, inp[16] + (size_t)ll * DFF, c1, c1 + 8192, cb * 128, lds, tid, wave, lane); }
              else { const int cb = it - 128; const float* sh = mod + (size_t)2 * 12288; float* cin = (float*)(ws + WS_CIN);
                  gemv_item<false>(inp[5] + (size_t)D * INC, INC, sh, sh + 12288, inp[6] + INC, cin, cin + INC, cb * 128, lds, tid, wave, lane); } }
          norm_phase(inp[0], inp[4], mod + 0 * D, mod + 1 * D, H, gw, NGW, lane); }
        GRID_SYNC();
    }
    for (int rep = 0; rep < 1 + ((REP_MASK >> 2) & 1); ++rep) {
    { PHASE_VARS const WOff wo = woff(l); pg8::Gemm g{H, (const bf16_t*)(ws + wo.in), T, INC, D}; pg8::StaticOrder S; S.init(T, INC, G, bx);
      pg8::EpiInProj E{U, VA, Qb, Kb, Vb, SGA, SGB, l == 0 ? inp[6] : (const float*)(ws + WS_CIN), l == 0 ? 0 : INC, l == 0 ? nullptr : (const float*)(ws + WS_SS) + T, (float*)(ws + WS_VST) + (size_t)l * 2 * T};
      pg8::gemm_phase<pg8::EpiInProj, pg8::StaticOrder, true, true>(lds, g, S, E); }
    GRID_SYNC(); }
    { PHASE_VARS
      { const int per = (NB * NH * 128 + G - 1) / G; int par = 0, prev_bh = -1;
        for (int k = 0; k < per; ++k) { const int it = bx * per + k; if (it >= NB * NH * 128) break;
            const int bh = it >> 7; const bool reuse = (k > 0) && (bh == prev_bh); par = reuse ? (par ^ 1) : 0; prev_bh = bh;
            attn_item(Qb, Kb, Vb, lse, it, par, reuse, lds, tid, wave, lane); } }
      for (int it = bx; it < T / 128; it += G) gate_item(U, VA, WsB + (size_t)l * 8 * 128 * 128, inp[7] + l * DA, inp[8] + l * DA, inp[10] + l * 8 * 128, (const float*)(ws + WS_VST) + (size_t)l * 2 * T, it, lds, tid, wave, lane); }
    GRID_SYNC();
    { PHASE_VARS combine_phase(Qb, lse, YB, gw, NGW, lane);
      if (l == 0) convert_layer_weights(inp, ws, 1, lds, gw, NGW, wave, lane); }
    GRID_SYNC();
    for (int rep = 0; rep < 1 + ((REP_MASK >> 5) & 1); ++rep) {
    { PHASE_VARS const WOff wo = woff(l); pg8::Gemm g{U, (const bf16_t*)(ws + wo.oa), T, D, DA}; pg8::StaticOrder S; S.init(T, D, G, bx);
      pg8::EpiMerge<1> E{MRG, SGA};
      pg8::gemm_phase<pg8::EpiMerge<1>, pg8::StaticOrder, true, true>(lds, g, S, E); }
    { PHASE_VARS const WOff wo = woff(l); pg8::Gemm g{YB, (const bf16_t*)(ws + wo.ob), T, D, DBO}; pg8::StaticOrder S; S.init(T, D, G, bx);
      pg8::EpiMerge<2> E{MRG, SGB};
      pg8::gemm_phase<pg8::EpiMerge<2>, pg8::StaticOrder, true, true>(lds, g, S, E); }
    GRID_SYNC(); }
    {
    { PHASE_VARS const WOff wo = woff(l); const float* modl = mod + (size_t)l * 2 * 12288; const float* xin = (l == 0) ? inp[0] : xo;
      pg8::Gemm g{MRG, (const bf16_t*)(ws + wo.out), T, D, D}; pg8::StaticOrder S; S.init(T, D, G, bx);
      if (l == 0) { pg8::EpiResid<0> E{inp[0], nullptr, XB, modl + 2 * D, nullptr, H, inp[14] + l * D, modl + 4 * D, (float*)(ws + WS_SS) + (size_t)(2 * l) * T};
          pg8::gemm_phase<pg8::EpiResid<0>, pg8::StaticOrder, true, true>(lds, g, S, E); }
      else { pg8::EpiResid<1> E{nullptr, XB, XB, modl + 2 * D, nullptr, H, inp[14] + l * D, modl + 4 * D, (float*)(ws + WS_SS) + (size_t)(2 * l) * T};
          pg8::gemm_phase<pg8::EpiResid<1>, pg8::StaticOrder, true, true>(lds, g, S, E); } }
    GRID_SYNC(); }
    for (int rep = 0; rep < 1 + ((REP_MASK >> 8) & 1); ++rep) {
    { PHASE_VARS const WOff wo = woff(l); pg8::Gemm g{H, (const bf16_t*)(ws + wo.w1), T, DFF, D}; pg8::StaticOrder S; S.init(T, DFF, G, bx);
      pg8::EpiMlp1 E{HID, (const float*)(ws + WS_C1) + (size_t)l * 2 * 8192, (const float*)(ws + WS_SS) + (size_t)(2 * l) * T};
      pg8::gemm_phase<pg8::EpiMlp1, pg8::StaticOrder, true, true>(lds, g, S, E); }
    GRID_SYNC(); }
    {
    { PHASE_VARS const WOff wo = woff(l); const float* modl = mod + (size_t)l * 2 * 12288;
      pg8::Gemm g{HID, (const bf16_t*)(ws + wo.w2), T, D, DFF}; pg8::StaticOrder S; S.init(T, D, G, bx);
      if (l == 0) { pg8::EpiResid<1> E{nullptr, XB, XB, modl + 5 * D, inp[18] + (size_t)l * D, H, inp[4] + D, mod + (size_t)2 * 12288 + 1 * D, (float*)(ws + WS_SS) + T};
          pg8::gemm_phase<pg8::EpiResid<1>, pg8::StaticOrder, true, true>(lds, g, S, E); }
      else { pg8::EpiResid<2> E{nullptr, XB, H, modl + 5 * D, inp[18] + (size_t)l * D, nullptr, nullptr, nullptr, (float*)(ws + WS_SS) + (size_t)3 * T};
          pg8::gemm_phase<pg8::EpiResid<2>, pg8::StaticOrder, true, true>(lds, g, S, E); } }
    GRID_SYNC(); }
}

__global__ void __launch_bounds__(512, 2) fwd_kernel(Args args) {
    extern __shared__ __attribute__((aligned(16))) unsigned char lds_raw[];
    LAS unsigned char* lds = (LAS unsigned char*)lds_raw;
    const int G = gridDim.x, bx = blockIdx.x, NGW = G * 8;
    if (threadIdx.x < 64) ((volatile LAS unsigned*)(lds + 131072))[threadIdx.x] = 0u;
    __syncthreads();
    (void)xcd_barrier_post((unsigned*)args.ws, (volatile LAS unsigned*)(lds + 131072 + 64));
    { PHASE_VARS
      for (int i = bx * 512 + tid; i < 2 * 8 * 128 * 128; i += G * 512) { const int s = i & 127, t = (i >> 7) & 127; WsB[i] = (bf16_t)f2bf(s <= t ? inp[9][i] : 0.f); }
      for (int i = bx * 512 + tid; i < 4 * T; i += G * 512) ((float*)(ws + WS_SS))[i] = 0.f;
      for (int i = bx * 512 + tid; i < 4 * T; i += G * 512) ((float*)(ws + WS_VST))[i] = 0.f;
      for (int it = bx; it < 192; it += G) { const int ll = it / 96, cb = it % 96;
        gemv_item<true>(inp[2] + (size_t)ll * D * 12288, 12288, inp[1], inp[1] + D, inp[3] + (size_t)ll * 12288, mod + (size_t)(ll * 2) * 12288, mod + (size_t)(ll * 2 + 1) * 12288, cb * 128, lds, tid, wave, lane); }
      convert_layer_weights(inp, ws, 0, lds, gw, NGW, wave, lane); }
    if (G > 65536) CG_SYNC();
    GRID_SYNC();
    for (int i = 0; i < EXTRA_SYNCS; ++i) GRID_SYNC();
    layer_phases<0>(args, lds, G, bx, NGW);
    layer_phases<1>(args, lds, G, bx, NGW);
    { PHASE_VARS final_norm_phase(H, (const float*)(ws + WS_SS) + (size_t)3 * T, xo, inp[19], gw, NGW, lane); }
}

extern "C" void kernel_launch(void* const* d_in, const int* in_sizes, int n_in, void* d_out, int out_size, void* d_ws, size_t ws_size, hipStream_t stream) {
    static int grid = 0;
    if (grid == 0) {
        if (n_in != 20 || ws_size < WS_END || out_size != T * D) { fprintf(stderr, "kernel_launch: unexpected problem (n_in %d, ws %zu, out %d)\n", n_in, ws_size, out_size); grid = -1; return; }
        int dev = 0, cus = 0, per_cu = 0;
        hipGetDevice(&dev); hipDeviceGetAttribute(&cus, hipDeviceAttributeMultiprocessorCount, dev);
        if (hipFuncSetAttribute((const void*)fwd_kernel, hipFuncAttributeMaxDynamicSharedMemorySize, LDS_BYTES) != hipSuccess) { fprintf(stderr, "hipFuncSetAttribute failed\n"); grid = -1; return; }
        hipOccupancyMaxActiveBlocksPerMultiprocessor(&per_cu, (const void*)fwd_kernel, 512, LDS_BYTES);
        if (per_cu < 1) { fprintf(stderr, "occupancy query says %d\n", per_cu); per_cu = 1; }
        (void)hipGetLastError();
        grid = cus * 1;
    }
    if (grid < 0) return;
    if (hipMemsetAsync(d_ws, 0, 16384, stream) != hipSuccess) { fprintf(stderr, "memset failed\n"); return; }
    Args a{};
    for (int i = 0; i < 20; ++i) a.in[i] = (const float*)d_in[i];
    a.out = (float*)d_out; a.ws = (unsigned char*)d_ws;
    void* kargs[] = {&a};
    hipError_t e = hipLaunchCooperativeKernel((const void*)fwd_kernel, dim3(grid), dim3(512), kargs, LDS_BYTES, stream);
    if (e != hipSuccess) fprintf(stderr, "cooperative launch failed: %s (grid %d)\n", hipGetErrorString(e), grid);
}
```
